# Optimizing an MI355X kernel written in HIP

```python
import math
import jax, jax.numpy as jnp
from jax import lax
import numpy as np


D_MODEL = 1024
BATCH = 4
SEQ = 8192
DEPTH = 2

HEAD_DIM = 64
SB_HEADS = 8
SB_WIDTH = SB_HEADS * HEAD_DIM
SB_BLOCK = 128
MOBA_HEADS = 8
MOBA_WIDTH = MOBA_HEADS * HEAD_DIM
MOBA_BLOCK = 256
MOBA_TOPK = 3
MOBA_Q_CHUNK = 32
SWA_HEADS = 8
SWA_KV_HEADS = 2
SWA_GROUP = SWA_HEADS // SWA_KV_HEADS
SWA_WIDTH = SWA_HEADS * HEAD_DIM
SWA_KV_WIDTH = SWA_KV_HEADS * HEAD_DIM
SWA_WINDOW = 128
REL_BUCKETS = 32
REL_MAX_DIST = 128
REL_HEADS = MOBA_HEADS + SWA_HEADS
RMS_EPS = 1e-6

SPLIT_SIZES = (SB_WIDTH, SB_WIDTH, SB_WIDTH, SB_WIDTH,
               MOBA_WIDTH, MOBA_WIDTH, MOBA_WIDTH, MOBA_WIDTH,
               SWA_WIDTH, SWA_KV_WIDTH, SWA_KV_WIDTH, SWA_WIDTH,
               D_MODEL, D_MODEL, D_MODEL)
D_IN = sum(SPLIT_SIZES)

kernel_name = "hybrid_sb_moba_swa_gated_block"


def rms_norm(x, w):
    xf = x.astype(jnp.float32)
    y = xf * lax.rsqrt(jnp.mean(xf * xf, axis=-1, keepdims=True) + RMS_EPS)
    return (y * w.astype(jnp.float32)).astype(x.dtype)


def _split_columns(u):
    parts, off = [], 0
    for n in SPLIT_SIZES:
        parts.append(u[..., off:off + n])
        off += n
    return parts


def _rel_bucket(dist):
    max_exact = REL_BUCKETS // 2
    n = jnp.maximum(dist, 0)
    nf = jnp.maximum(n, 1).astype(jnp.float32)
    large = max_exact + (jnp.log(nf / max_exact) / math.log(REL_MAX_DIST / max_exact)
                         * (REL_BUCKETS - max_exact)).astype(jnp.int32)
    large = jnp.minimum(large, REL_BUCKETS - 1)
    return jnp.where(n < max_exact, n, large)


def stick_breaking_attention(q, k, v):
    B, H, S, dh = q.shape
    nq = S // SB_BLOCK
    scale = dh ** -0.5
    qb = q.reshape(B, H, nq, SB_BLOCK, dh).transpose(2, 0, 1, 3, 4)
    kpos = jnp.arange(S)

    def block(args):
        qi, i = args
        qpos = i * SB_BLOCK + jnp.arange(SB_BLOCK)
        z = jnp.einsum('bhqd,bhkd->bhqk', qi, k).astype(jnp.float32) * scale
        past = kpos[None, :] < qpos[:, None]
        log_1m = jnp.where(past, jax.nn.log_sigmoid(-z), 0.0)
        between = lax.cumsum(log_1m, axis=3, reverse=True) - log_1m
        w = jnp.where(past, jnp.exp(jax.nn.log_sigmoid(z) + between), 0.0)
        return jnp.einsum('bhqk,bhkd->bhqd', w.astype(v.dtype), v)

    out = lax.map(block, (qb, jnp.arange(nq)))
    return out.transpose(1, 2, 0, 3, 4).reshape(B, H, S, dh)


def moba_attention(q, k, v, rel_table):
    B, H, S, dh = q.shape
    scale = dh ** -0.5
    nb = -(-S // MOBA_BLOCK)
    pad = nb * MOBA_BLOCK - S
    padding = ((0, 0), (0, 0), (0, pad), (0, 0))
    kb = jnp.pad(k, padding).reshape(B, H, nb, MOBA_BLOCK, dh)
    vb = jnp.pad(v, padding).reshape(B, H, nb, MOBA_BLOCK, dh)
    kmean = kb.astype(jnp.float32).mean(axis=3).astype(k.dtype)

    pos = jnp.arange(S)
    own = pos // MOBA_BLOCK
    gate = jnp.einsum('bhsd,bhnd->bhsn', q, kmean).astype(jnp.float32)
    past_blk = jnp.arange(nb)[None, :] < own[:, None]
    gate = jnp.where(past_blk, gate, -jnp.inf)
    k_sel = min(MOBA_TOPK, nb)
    _, idx = lax.top_k(gate, k_sel)
    valid = idx < own[:, None]

    nc = S // MOBA_Q_CHUNK
    C = MOBA_Q_CHUNK
    qc = q.reshape(B, H, nc, C, dh).transpose(2, 0, 1, 3, 4)
    idxc = idx.reshape(B, H, nc, C, k_sel).transpose(2, 0, 1, 3, 4)
    validc = valid.reshape(B, H, nc, C, k_sel).transpose(2, 0, 1, 3, 4)
    table = rel_table.T
    bi = jnp.arange(B)[:, None, None, None]
    hi = jnp.arange(H)[None, :, None, None]
    offs = jnp.arange(MOBA_BLOCK)
    n_sel = k_sel * MOBA_BLOCK

    def chunk(args):
        qi, ii, vi, c = args
        start = c * C
        qpos = start + jnp.arange(C)
        ob = start // MOBA_BLOCK
        ks = kb[bi, hi, ii].reshape(B, H, C, n_sel, dh)
        vs = vb[bi, hi, ii].reshape(B, H, C, n_sel, dh)
        kpos_sel = (ii[..., None] * MOBA_BLOCK + offs).reshape(B, H, C, n_sel)
        s_sel = jnp.einsum('bhqd,bhqkd->bhqk', qi, ks).astype(jnp.float32) * scale
        s_sel = s_sel + table[hi, _rel_bucket(qpos[:, None] - kpos_sel)]
        s_sel = jnp.where(jnp.repeat(vi, MOBA_BLOCK, axis=-1), s_sel, -jnp.inf)
        ko = lax.dynamic_index_in_dim(kb, ob, axis=2, keepdims=False)
        vo = lax.dynamic_index_in_dim(vb, ob, axis=2, keepdims=False)
        d_own = qpos[:, None] - (ob * MOBA_BLOCK + offs)[None, :]
        s_own = jnp.einsum('bhqd,bhkd->bhqk', qi, ko).astype(jnp.float32) * scale
        s_own = jnp.where(d_own >= 0, s_own + table[:, _rel_bucket(d_own)], -jnp.inf)
        p = jax.nn.softmax(jnp.concatenate([s_sel, s_own], axis=-1), axis=-1).astype(v.dtype)
        return (jnp.einsum('bhqk,bhqkd->bhqd', p[..., :n_sel], vs)
                + jnp.einsum('bhqk,bhkd->bhqd', p[..., n_sel:], vo))

    out = lax.map(chunk, (qc, idxc, validc, jnp.arange(nc)))
    return out.transpose(1, 2, 0, 3, 4).reshape(B, H, S, dh)


def swa_attention(q, k, v, sinks, rel_table):
    B, S, Hq, dh = q.shape
    W = SWA_WINDOW
    nb = S // W
    scale = dh ** -0.5
    qb = q.reshape(B, nb, W, SWA_KV_HEADS, SWA_GROUP, dh)
    kb = k.reshape(B, nb, W, SWA_KV_HEADS, dh)
    vb = v.reshape(B, nb, W, SWA_KV_HEADS, dh)
    prev = ((0, 0), (1, 0), (0, 0), (0, 0), (0, 0))
    kw = jnp.concatenate([jnp.pad(kb, prev)[:, :-1], kb], axis=2)
    vw = jnp.concatenate([jnp.pad(vb, prev)[:, :-1], vb], axis=2)
    s = jnp.einsum('bnqhgd,bnchd->bnhgqc', qb, kw).astype(jnp.float32) * scale
    ci = jnp.arange(2 * W)[None, :]
    dist = jnp.arange(W)[:, None] + W - ci
    bias = rel_table[_rel_bucket(dist)].astype(jnp.float32)
    bias = bias.transpose(2, 0, 1).reshape(SWA_KV_HEADS, SWA_GROUP, W, 2 * W)
    in_band = (dist >= 0) & (dist < W)
    key_exists = (jnp.arange(nb)[:, None] * W - W + ci) >= 0
    mask = in_band[None] & key_exists[:, None, :]
    s = jnp.where(mask[None, :, None, None], s + bias, -jnp.inf)
    sink = sinks.astype(jnp.float32).reshape(SWA_KV_HEADS, SWA_GROUP)[None, None, :, :, None, None]
    m = jnp.maximum(s.max(axis=-1, keepdims=True), sink)
    e = jnp.exp(s - m)
    p = (e / (e.sum(axis=-1, keepdims=True) + jnp.exp(sink - m))).astype(v.dtype)
    out = jnp.einsum('bnhgqc,bnchd->bnqhgd', p, vw)
    return out.reshape(B, S, Hq, dh)


def hybrid_layer(x, norm_w, w_in, w_proj_a, w_proj_b, w_proj_c, w_out, sinks, rel_bias):
    B, S, _ = x.shape
    h = rms_norm(x, norm_w)
    u = jnp.einsum('bsd,de->bse', h, w_in)
    (qa, ka, va, ga, qb, kb, vb, gb, qc, kc, vc, gc, ma, mb, mc) = _split_columns(u)

    def bhsd(t, n):
        return t.reshape(B, S, n, HEAD_DIM).transpose(0, 2, 1, 3)

    ya = stick_breaking_attention(bhsd(qa, SB_HEADS), bhsd(ka, SB_HEADS), bhsd(va, SB_HEADS))
    ya = ya.transpose(0, 2, 1, 3).reshape(B, S, SB_WIDTH)
    yb = moba_attention(bhsd(qb, MOBA_HEADS), bhsd(kb, MOBA_HEADS), bhsd(vb, MOBA_HEADS),
                        rel_bias[:, :MOBA_HEADS])
    yb = yb.transpose(0, 2, 1, 3).reshape(B, S, MOBA_WIDTH)
    yc = swa_attention(qc.reshape(B, S, SWA_HEADS, HEAD_DIM),
                       kc.reshape(B, S, SWA_KV_HEADS, HEAD_DIM),
                       vc.reshape(B, S, SWA_KV_HEADS, HEAD_DIM),
                       sinks, rel_bias[:, MOBA_HEADS:])
    yc = yc.reshape(B, S, SWA_WIDTH)

    ya = jnp.einsum('bse,ed->bsd', ya * jax.nn.silu(ga), w_proj_a)
    yb = jnp.einsum('bse,ed->bsd', yb * jax.nn.silu(gb), w_proj_b)
    yc = jnp.einsum('bse,ed->bsd', yc * jax.nn.silu(gc), w_proj_c)
    merged = jax.nn.sigmoid(ma) * ya + jax.nn.sigmoid(mb) * yb + jax.nn.sigmoid(mc) * yc
    return x + jnp.einsum('bsd,de->bse', merged, w_out)


def setup_inputs(seed: int = 0) -> dict:
    key = jax.random.key(seed)
    ks = jax.random.split(key, 10)
    f32 = jnp.float32
    x = jax.random.normal(ks[0], (BATCH, SEQ, D_MODEL), f32)
    norm_w = 1.0 + 0.02 * jax.random.normal(ks[1], (DEPTH, D_MODEL), f32)
    w_in = jax.random.normal(ks[2], (DEPTH, D_MODEL, D_IN), f32) * D_MODEL ** -0.5
    w_proj_a = jax.random.normal(ks[3], (DEPTH, SB_WIDTH, D_MODEL), f32) * SB_WIDTH ** -0.5
    w_proj_b = jax.random.normal(ks[4], (DEPTH, MOBA_WIDTH, D_MODEL), f32) * MOBA_WIDTH ** -0.5
    w_proj_c = jax.random.normal(ks[5], (DEPTH, SWA_WIDTH, D_MODEL), f32) * SWA_WIDTH ** -0.5
    w_out = jax.random.normal(ks[6], (DEPTH, D_MODEL, D_MODEL), f32) * D_MODEL ** -0.5
    sinks = 0.5 * jax.random.normal(ks[7], (DEPTH, SWA_HEADS), f32)
    rel_bias = 0.5 * jax.random.normal(ks[8], (REL_BUCKETS, REL_HEADS), f32)
    final_norm_w = 1.0 + 0.02 * jax.random.normal(ks[9], (D_MODEL,), f32)
    return {"x": x, "norm_w": norm_w, "w_in": w_in, "w_proj_a": w_proj_a,
            "w_proj_b": w_proj_b, "w_proj_c": w_proj_c, "w_out": w_out,
            "sinks": sinks, "rel_bias": rel_bias, "final_norm_w": final_norm_w}


def reference(x, norm_w, w_in, w_proj_a, w_proj_b, w_proj_c, w_out, sinks, rel_bias, final_norm_w):
    for layer in range(DEPTH):
        x = hybrid_layer(x, norm_w[layer], w_in[layer], w_proj_a[layer], w_proj_b[layer],
                         w_proj_c[layer], w_out[layer], sinks[layer], rel_bias)
    return rms_norm(x, final_norm_w)
```

```cpp
#include <hip/hip_runtime.h>
#include <hip/hip_cooperative_groups.h>
#include <cstdio>
#include <cstdint>
namespace cg = cooperative_groups;

#define LAS __attribute__((address_space(3)))
#define DI __device__ __forceinline__
typedef unsigned short bf16_t;
typedef short bf16x8 __attribute__((ext_vector_type(8)));
typedef short s16x4 __attribute__((ext_vector_type(4)));
typedef float f32x4 __attribute__((ext_vector_type(4)));
typedef float f32x16 __attribute__((ext_vector_type(16)));
typedef unsigned u32x4 __attribute__((ext_vector_type(4)));
typedef unsigned u32x2 __attribute__((ext_vector_type(2)));

constexpr int BATCH = 4, SEQ = 8192, DM = 1024, T = BATCH * SEQ, DEPTH = 2;
constexpr int DIN = 8448, NU = 5376, PITCH = 6400, XB_COL = 5376;
constexpr int C_QA = 0, C_KA = 512, C_VA = 1024, C_GA = 1536, C_QB = 2048, C_KB = 2560, C_VB = 3072, C_GB = 3584, C_QC = 4096, C_KC = 4608, C_VC = 4736, C_GC = 4864;
constexpr int C_MERGED = 512;
constexpr int C_GS = 2560;
constexpr float LOG2E = 1.4426950408889634f;
constexpr float QSCALE = 0.125f * LOG2E;
constexpr float RMS_EPS = 1e-6f;
constexpr float NEG_INF = -__builtin_huge_valf();

constexpr size_t MiB = 1u << 20;
constexpr size_t WS_WIN = 0;
constexpr size_t WS_WP = 33 * MiB;
constexpr size_t WS_WO = 45 * MiB;
constexpr size_t WS_SSQ = 49 * MiB;
constexpr size_t WS_KPART = 51 * MiB;
constexpr size_t WS_ACT = 52 * MiB;
constexpr size_t WS_SEL = 452 * MiB;
constexpr size_t WS_ML = 453 * MiB;
constexpr size_t WS_CTL = 462 * MiB;
constexpr size_t WS_END = 463 * MiB;

constexpr int LDS_MAIN = 131072;
constexpr int LDS_TABM = LDS_MAIN;
constexpr int LDS_TABS = LDS_TABM + 8 * 132 * 4;
constexpr int LDS_CTL = LDS_TABS + 8 * 128 * 4;
constexpr int LDS_BYTES = 143360;

DI unsigned cvtpk(float lo, float hi) { typedef float f2 __attribute__((ext_vector_type(2))); typedef __bf16 b2 __attribute__((ext_vector_type(2))); f2 v = {lo, hi}; b2 b = __builtin_convertvector(v, b2); return __builtin_bit_cast(unsigned, b); }
DI float bf2f(unsigned short b) { return __uint_as_float(((unsigned)b) << 16); }
DI float bflo(unsigned w) { return __uint_as_float(w << 16); }
DI float bfhi(unsigned w) { return __uint_as_float(w & 0xffff0000u); }
DI float wave_sum(float v) {
#pragma unroll
    for (int o = 1; o < 64; o <<= 1) v += __shfl_xor(v, o);
    return v;
}
DI float fast_exp2(float x) { return __builtin_amdgcn_exp2f(x); }
DI float fast_log2(float x) { return __builtin_amdgcn_logf(x); }
DI float fast_rcp(float x) { return __builtin_amdgcn_rcpf(x); }
DI float sigmoidf_(float x) { return fast_rcp(1.f + fast_exp2(-x * LOG2E)); }

#define XB_TMO      128
#define XB_XCNT(j)  (256  + 64 * (j))
#define XB_XSUB(j)  (1280 + 64 * (j))
#define XB_XGEN(j)  (2304 + 64 * (j))
#define XB_TOP      3328
#define XB_TOPGEN   3392
#define XCD_BAR_WORDS 3456
#define XB_SPIN_CAP (1u << 18)
DI unsigned xb_ld(unsigned* p)              { return __hip_atomic_load(p, __ATOMIC_RELAXED, __HIP_MEMORY_SCOPE_AGENT); }
DI unsigned xb_add(unsigned* p, unsigned v) { return __hip_atomic_fetch_add(p, v, __ATOMIC_RELAXED, __HIP_MEMORY_SCOPE_AGENT); }
DI unsigned xb_xcc_id() { return (unsigned)__builtin_amdgcn_s_getreg((3 << 11) | 20) & 0xFu; }
#define XB_SPIN(cond, bar) do { unsigned _sp = 0; while (cond) { __builtin_amdgcn_s_sleep(1); \
    if ((++_sp & 255u) == 0u) { if (xb_ld(&(bar)[XB_TMO])) break; if (_sp > XB_SPIN_CAP) { atomicAdd(&(bar)[XB_TMO], 1u); break; } } } } while (0)
struct XcdBarrier { unsigned* bar; unsigned x; volatile LAS unsigned* st; };
DI XcdBarrier xcd_barrier_post(unsigned* bar, volatile LAS unsigned* st) {
    XcdBarrier b; b.bar = bar; b.x = xb_xcc_id(); b.st = st;
    if (threadIdx.x == 0) (void)xb_add(&bar[XB_XCNT(b.x)], 1u);
    return b;
}
DI void xcd_barrier_complete(unsigned* bar, unsigned x, unsigned& nloc, unsigned& nx) {
    const unsigned G = gridDim.x * gridDim.y * gridDim.z;
    unsigned sum, cnt, mine, sp = 0u;
    for (;;) {
        sum = 0u; cnt = 0u; mine = 0u;
#pragma unroll
        for (unsigned j = 0; j < 16; ++j) { const unsigned c = xb_ld(&bar[XB_XCNT(j)]); sum += c; cnt += (c > 0u) ? 1u : 0u; mine = (j == x) ? c : mine; }
        if (sum == G) break;
        __builtin_amdgcn_s_sleep(1);
        if ((++sp & 255u) == 0u) { if (xb_ld(&bar[XB_TMO])) break; if (sp > XB_SPIN_CAP) { atomicAdd(&bar[XB_TMO], 1u); break; } }
    }
    nloc = mine > 0u ? mine : 1u; nx = cnt > 0u ? cnt : 1u;
}
DI void xcd_barrier(const XcdBarrier& b) {
    asm volatile("s_waitcnt vmcnt(0)" ::: "memory");
    __syncthreads();
    if (threadIdx.x == 0) {
        unsigned* bar = b.bar;
        __builtin_amdgcn_s_waitcnt(0);
        unsigned nloc = b.st[0], nx = b.st[1];
        if (nloc == 0u) { xcd_barrier_complete(bar, b.x, nloc, nx); b.st[0] = nloc; b.st[1] = nx; }
        const unsigned old = xb_add(&bar[XB_XSUB(b.x)], 1u);
        const unsigned gen = old / nloc;
        if (old + 1u == (gen + 1u) * nloc) {
            __builtin_amdgcn_fence(__ATOMIC_RELEASE, "agent");
            asm volatile("s_waitcnt vmcnt(0)" ::: "memory");
            const unsigned og = xb_add(&bar[XB_TOP], 1u);
            const unsigned tg = og / nx;
            if (og + 1u == (tg + 1u) * nx) xb_add(&bar[XB_TOPGEN], 1u);
            else XB_SPIN(xb_ld(&bar[XB_TOPGEN]) == tg, bar);
            __builtin_amdgcn_fence(__ATOMIC_ACQUIRE, "agent");
            xb_add(&bar[XB_XGEN(b.x)], 1u);
            asm volatile("s_waitcnt vmcnt(0)" ::: "memory");
        } else {
            XB_SPIN(xb_ld(&bar[XB_XGEN(b.x)]) == gen, bar);
            __builtin_amdgcn_fence(__ATOMIC_ACQUIRE, "agent");
            asm volatile("s_waitcnt vmcnt(0)" ::: "memory");
        }
    }
    __syncthreads();
}

struct Params {
    const float* x; const float* norm_w; const float* w_in; const float* w_pa; const float* w_pb; const float* w_pc; const float* w_out;
    const float* sinks; const float* rel_bias; const float* fnw; float* out; unsigned char* ws;
};

namespace pg8 {
constexpr int BM = 256, BK = 64, HALF = 128, HTB = HALF * BK * 2, STAGE_BYTES = 8 * HTB, NXCD = 8, WGM = 8;
__host__ __device__ __forceinline__ int lds_byte(int r, int c) { const int st = (r >> 4) * 2 + (c >> 5), rr = r & 15, cc = c & 31, ob = rr * 64 + cc * 2; return st * 1024 + (ob ^ (((ob >> 9) & 1) << 5)); }
__host__ __device__ __forceinline__ void stage_rc(int b, int& R, int& C) { const int st = b / 1024, sb = b % 1024, swz = sb ^ (((sb >> 9) & 1) << 5); R = (st >> 1) * 16 + swz / 64; C = (st & 1) * 32 + (swz % 64) / 2; }
__host__ __device__ __forceinline__ int perm32(int rho) { const int n = rho >> 4, i = rho & 15; return 8 * (i >> 2) + 4 * n + (i & 3); }

struct Tile { int pm, pn; };
struct GUnit { const char* A; const char* B; int nt; int pm, pn, z; };

struct TileOrder {
    int nM, nN, nwg, G, c;
    __device__ void init(int nM_, int nN_, int G_, int c_) { nM = nM_; nN = nN_; nwg = nM * nN; G = G_; c = c_; }
    __device__ bool tile(int i, Tile& u) const {
        const long L = (long)i * G + c; if (L >= nwg) return false;
        int wgid = (int)L; { const int q = nwg / NXCD, r = nwg % NXCD, xcd = wgid % NXCD, off = wgid / NXCD; wgid = (xcd < r ? xcd * (q + 1) : r * (q + 1) + (xcd - r) * q) + off; }
        const int nig = WGM * nN, gid = wgid / nig, fm = gid * WGM, gsz = (nM - fm) < WGM ? (nM - fm) : WGM;
        u.pm = fm + ((wgid % nig) % gsz); u.pn = (wgid % nig) / gsz; return true;
    }
};

template <class Epi, class Sched>
__device__ __forceinline__ void gemm_phase(LAS unsigned char* lds, const int lda, const int ldb, const Sched& S, const Epi& E) {
    int tid = threadIdx.x; asm volatile("" : "+v"(tid));
    const int wid = __builtin_amdgcn_readfirstlane(tid >> 6), lane = tid & 63, wr = wid >> 2, wc = wid & 3, fr = lane & 15, fq = lane >> 4;
    unsigned voffA[2], voffB[2];
#pragma unroll
    for (int i = 0; i < 2; ++i) { int R, C; stage_rc(tid * 16 + i * 8192, R, C); const int Rb = (R & ~31) + perm32(R & 31);
        voffA[i] = (unsigned)(R * lda + C) * 2u; voffB[i] = (unsigned)(Rb * ldb + C) * 2u; }
    const size_t kstep = (size_t)(BK * 2);
    const size_t hstepA = (size_t)HALF * lda * 2, hstepB = (size_t)HALF * ldb * 2;
    const unsigned ldsw = (unsigned)wid * 1024u;
    const int aoff = lds_byte(wr * 64 + fr, fq * 8), boff = lds_byte(wc * 32 + fr, fq * 8);
#define PG8_SA(b, h) (((b) * 2 + (h)) * HTB)
#define PG8_SB(b, h) ((4 + (b) * 2 + (h)) * HTB)
#define PG8_STAGE(bufoff, gbase, voff) do { _Pragma("unroll") for (int _i = 0; _i < 2; ++_i) \
        __builtin_amdgcn_global_load_lds((const unsigned*)((const char*)(gbase) + (voff)[_i]), (LAS unsigned*)(lds + (bufoff) + ldsw + _i * 8192), 16, 0, 0); } while (0)
#define PG8_LDA(dst, b, h) do { _Pragma("unroll") for (int m = 0; m < 4; ++m) _Pragma("unroll") for (int k = 0; k < 2; ++k) dst[m][k] = *(const LAS bf16x8*)(lds + PG8_SA(b, h) + aoff + m * 2048 + k * 1024); } while (0)
#define PG8_LDB(dst, b, h) do { _Pragma("unroll") for (int n = 0; n < 2; ++n) _Pragma("unroll") for (int k = 0; k < 2; ++k) dst[n][k] = *(const LAS bf16x8*)(lds + PG8_SB(b, h) + boff + n * 2048 + k * 1024); } while (0)
#define PG8_MMA(ai, bj, At, Bt) do { __builtin_amdgcn_s_setprio(1); _Pragma("unroll") for (int m = 0; m < 4; ++m) _Pragma("unroll") for (int n = 0; n < 2; ++n) _Pragma("unroll") for (int k = 0; k < 2; ++k) \
        acc[ai][bj][m][n] = __builtin_amdgcn_mfma_f32_16x16x32_bf16(Bt[n][k], At[m][k], acc[ai][bj][m][n], 0, 0, 0); __builtin_amdgcn_s_setprio(0); } while (0)
#define PG8_WAIT_V(n) asm volatile("s_waitcnt vmcnt(" #n ")" ::: "memory")
#define PG8_WAIT_L(n) asm volatile("s_waitcnt lgkmcnt(" #n ")" ::: "memory")
#define PG8_BAR __builtin_amdgcn_s_barrier()
#define PG8_SCHED __builtin_amdgcn_sched_barrier(0)
    GUnit cur, nxt; int ui = 0;
    if (!S.next(0, cur)) return;
    f32x4 acc[2][2][4][2];
#pragma unroll
    for (int a = 0; a < 2; ++a)
#pragma unroll
        for (int b = 0; b < 2; ++b)
#pragma unroll
            for (int m = 0; m < 4; ++m)
#pragma unroll
                for (int n = 0; n < 2; ++n) acc[a][b][m][n] = (f32x4){0.f, 0.f, 0.f, 0.f};
    bf16x8 At[4][2], B0[2][2], B1[2][2];
    const char* cA = cur.A; const char* cB = cur.B;
    PG8_STAGE(PG8_SB(0, 0), cB, voffB); PG8_STAGE(PG8_SB(0, 1), cB + hstepB, voffB); PG8_STAGE(PG8_SA(0, 0), cA, voffA); PG8_STAGE(PG8_SA(0, 1), cA + hstepA, voffA);
    if (wr == 1) PG8_BAR;
    PG8_WAIT_V(2); PG8_BAR;
    PG8_STAGE(PG8_SB(1, 0), cB + kstep, voffB); PG8_STAGE(PG8_SA(1, 0), cA + kstep, voffA); PG8_STAGE(PG8_SB(1, 1), cB + hstepB + kstep, voffB);
    PG8_WAIT_V(6); PG8_BAR;
    for (;;) {
        const bool has_next = S.next(ui + 1, nxt);
        const char* nA = has_next ? nxt.A : cA; const char* nB = has_next ? nxt.B : cB;
        const int nt = cur.nt;
        for (int t = 0; t < nt; t += 2) {
            const bool last = (t == nt - 2);
            const char* a1 = cA + (size_t)(t + 1) * kstep;
            const char* a2 = last ? nA : cA + (size_t)(t + 2) * kstep; const char* b2 = last ? nB : cB + (size_t)(t + 2) * kstep;
            const char* a3 = a2 + kstep; const char* b3 = b2 + kstep;
            PG8_LDB(B0, 0, 0); PG8_LDB(B1, 0, 1); PG8_SCHED; PG8_LDA(At, 0, 0); PG8_STAGE(PG8_SA(1, 1), a1 + hstepA, voffA);
            PG8_WAIT_V(8); PG8_WAIT_L(0); PG8_BAR; PG8_MMA(0, 0, At, B0); PG8_MMA(0, 1, At, B1); PG8_BAR; PG8_SCHED;
            PG8_LDA(At, 0, 1); PG8_STAGE(PG8_SB(0, 0), b2, voffB); PG8_STAGE(PG8_SB(0, 1), b2 + hstepB, voffB); PG8_STAGE(PG8_SA(0, 0), a2, voffA);
            PG8_WAIT_V(8); PG8_WAIT_L(0); PG8_BAR; PG8_MMA(1, 0, At, B0); PG8_MMA(1, 1, At, B1); PG8_BAR; PG8_SCHED;
            PG8_LDB(B0, 1, 0); PG8_LDB(B1, 1, 1); PG8_SCHED; PG8_LDA(At, 1, 0); PG8_STAGE(PG8_SA(0, 1), a2 + hstepA, voffA);
            PG8_WAIT_V(8); PG8_WAIT_L(0); PG8_BAR; PG8_MMA(0, 0, At, B0); PG8_MMA(0, 1, At, B1); PG8_BAR; PG8_SCHED;
            PG8_LDA(At, 1, 1); PG8_STAGE(PG8_SB(1, 0), b3, voffB); PG8_STAGE(PG8_SB(1, 1), b3 + hstepB, voffB); PG8_STAGE(PG8_SA(1, 0), a3, voffA);
            PG8_WAIT_V(8); PG8_WAIT_L(0); PG8_BAR; PG8_MMA(1, 0, At, B0); PG8_MMA(1, 1, At, B1); PG8_BAR; PG8_SCHED;
        }
        if (wr == 0) PG8_BAR;
        E(acc, cur, wr, wc, fr, fq);
        if (!has_next) break;
#pragma unroll
        for (int a = 0; a < 2; ++a)
#pragma unroll
            for (int b = 0; b < 2; ++b)
#pragma unroll
                for (int m = 0; m < 4; ++m)
#pragma unroll
                    for (int n = 0; n < 2; ++n) acc[a][b][m][n] = (f32x4){0.f, 0.f, 0.f, 0.f};
        cur = nxt; cA = nA; cB = nB; ++ui;
        if (wr == 1) PG8_BAR;
    }
    PG8_WAIT_V(0);
    PG8_BAR;
#undef PG8_SA
#undef PG8_SB
#undef PG8_STAGE
#undef PG8_LDA
#undef PG8_LDB
#undef PG8_MMA
#undef PG8_WAIT_V
#undef PG8_WAIT_L
#undef PG8_BAR
#undef PG8_SCHED
}
}

struct SchedIn {
    pg8::TileOrder O; const char* act; const char* win;
    __device__ bool next(int i, pg8::GUnit& u) const { pg8::Tile t; if (!O.tile(i, t)) return false;
        u.pm = t.pm; u.pn = t.pn; u.z = 0; u.nt = 16;
        u.A = act + ((size_t)t.pm * 256 * PITCH + XB_COL) * 2; u.B = win + (size_t)t.pn * 256 * 1024 * 2; return true; }
};
struct SchedMerge {
    pg8::TileOrder O; const char* act; const char* win; const char* wp;
    __device__ bool next(int i, pg8::GUnit& u) const { pg8::Tile t; const int ti = i / 6, z = i - ti * 6; if (!O.tile(ti, t)) return false;
        const int br = z >> 1; u.pm = t.pm; u.pn = t.pn; u.z = z;
        if (z & 1) { u.nt = 8; u.A = act + ((size_t)t.pm * 256 * PITCH + br * 2048) * 2; u.B = wp + ((size_t)(br * 1024 + t.pn * 256) * 1024) * 2; }
        else { u.nt = 16; u.A = act + ((size_t)t.pm * 256 * PITCH + XB_COL) * 2; u.B = win + ((size_t)(NU + br * 1024 + t.pn * 256) * 1024) * 2; }
        return true; }
};
struct SchedOut {
    pg8::TileOrder O; const char* act; const char* wo;
    __device__ bool next(int i, pg8::GUnit& u) const { pg8::Tile t; if (!O.tile(i, t)) return false;
        u.pm = t.pm; u.pn = t.pn; u.z = 0; u.nt = 16;
        u.A = act + ((size_t)t.pm * 256 * PITCH + C_MERGED) * 2; u.B = wo + (size_t)t.pn * 256 * 1024 * 2; return true; }
};

DI float row_rstd(const float* ssq, int row) {
    const f32x4* p = (const f32x4*)(ssq + (size_t)row * 16);
    const f32x4 a = p[0], b = p[1], c = p[2], d = p[3];
    const float s = ((a.x + a.y) + (a.z + a.w)) + ((b.x + b.y) + (b.z + b.w)) + ((c.x + c.y) + (c.z + c.w)) + ((d.x + d.y) + (d.z + d.w));
    return 1.0f / sqrtf(s * (1.0f / DM) + RMS_EPS);
}
DI void rows_rstd8(float (&rs)[2][4], const float* ssq, int row0, int fq) {
    f32x4 part[2][4];
#pragma unroll
    for (int ai = 0; ai < 2; ++ai)
#pragma unroll
        for (int m = 0; m < 4; ++m) part[ai][m] = *(const f32x4*)(ssq + (size_t)(row0 + ai * 128 + m * 16) * 16 + fq * 4);
#pragma unroll
    for (int ai = 0; ai < 2; ++ai)
#pragma unroll
        for (int m = 0; m < 4; ++m) { const f32x4 q = part[ai][m]; float t = (q.x + q.y) + (q.z + q.w); t += __shfl_xor(t, 16); t += __shfl_xor(t, 32);
            rs[ai][m] = 1.0f / sqrtf(t * (1.0f / DM) + RMS_EPS); }
}
struct EpiIn {
    bf16_t* act; const float* ssq; float* kpart; bool use_rs;
    DI void operator()(f32x4 (&acc)[2][2][4][2], const pg8::GUnit& u, int wr, int wc, int fr, int fq) const {
        const int row0 = u.pm * 256 + wr * 64 + fr; const int col0 = u.pn * 256 + wc * 32 + 8 * fq;
        const bool isq = (u.pn < 2) || (u.pn == 8) || (u.pn == 9) || (u.pn == 16) || (u.pn == 17);
        const float sc = isq ? QSCALE : 1.0f;
        const bool iskb = (u.pn == 10) || (u.pn == 11);
        float rs8[2][4];
        if (use_rs) rows_rstd8(rs8, ssq, row0, fq);
        else {
#pragma unroll
            for (int ai = 0; ai < 2; ++ai)
#pragma unroll
                for (int m = 0; m < 4; ++m) rs8[ai][m] = 1.0f;
        }
        f32x4 cs[2][2];
#pragma unroll
        for (int bj = 0; bj < 2; ++bj)
#pragma unroll
            for (int n = 0; n < 2; ++n) cs[bj][n] = (f32x4){0.f, 0.f, 0.f, 0.f};
#pragma unroll
        for (int ai = 0; ai < 2; ++ai)
#pragma unroll
            for (int m = 0; m < 4; ++m) {
                const int row = row0 + ai * 128 + m * 16;
                const float rs = rs8[ai][m] * sc;
                bf16_t* rowp = act + (size_t)row * PITCH + col0;
#pragma unroll
                for (int bj = 0; bj < 2; ++bj) {
                    const f32x4 v0 = acc[ai][bj][m][0] * rs, v1 = acc[ai][bj][m][1] * rs;
                    cs[bj][0] += v0; cs[bj][1] += v1;
                    u32x4 w; w.x = cvtpk(v0[0], v0[1]); w.y = cvtpk(v0[2], v0[3]); w.z = cvtpk(v1[0], v1[1]); w.w = cvtpk(v1[2], v1[3]);
                    *(u32x4*)(rowp + bj * 128) = w;
                }
            }
        if (iskb) {
#pragma unroll
            for (int bj = 0; bj < 2; ++bj)
#pragma unroll
                for (int n = 0; n < 2; ++n)
#pragma unroll
                    for (int j = 0; j < 4; ++j) { float v = cs[bj][n][j]; v += __shfl_xor(v, 1); v += __shfl_xor(v, 2); v += __shfl_xor(v, 4); v += __shfl_xor(v, 8); cs[bj][n][j] = v; }
            if (fr == 0) {
                float* kp = kpart + ((size_t)u.pm * 2 + wr) * 512 + (u.pn - 10) * 256 + wc * 32 + 8 * fq;
#pragma unroll
                for (int bj = 0; bj < 2; ++bj) { *(f32x4*)(kp + bj * 128) = cs[bj][0]; *(f32x4*)(kp + bj * 128 + 4) = cs[bj][1]; }
            }
        }
    }
};
struct EpiMerge {
    bf16_t* act; const float* ssq; bool use_rs;
    DI void operator()(f32x4 (&acc)[2][2][4][2], const pg8::GUnit& u, int wr, int wc, int fr, int fq) const {
        const int row0 = u.pm * 256 + wr * 64 + fr; const int col0 = u.pn * 256 + wc * 32 + 8 * fq;
        const int z = u.z;
        if ((z & 1) == 0) {
            float rs8[2][4];
            if (use_rs) rows_rstd8(rs8, ssq, row0, fq);
            else {
#pragma unroll
                for (int ai = 0; ai < 2; ++ai)
#pragma unroll
                    for (int m = 0; m < 4; ++m) rs8[ai][m] = 1.0f;
            }
#pragma unroll
            for (int ai = 0; ai < 2; ++ai)
#pragma unroll
                for (int m = 0; m < 4; ++m) {
                    bf16_t* gp = act + (size_t)(row0 + ai * 128 + m * 16) * PITCH + C_GS + col0;
                    const float rs = rs8[ai][m];
#pragma unroll
                    for (int bj = 0; bj < 2; ++bj) {
                        const f32x4 v0 = acc[ai][bj][m][0] * rs, v1 = acc[ai][bj][m][1] * rs;
                        u32x4 w; w.x = cvtpk(sigmoidf_(v0[0]), sigmoidf_(v0[1])); w.y = cvtpk(sigmoidf_(v0[2]), sigmoidf_(v0[3]));
                        w.z = cvtpk(sigmoidf_(v1[0]), sigmoidf_(v1[1])); w.w = cvtpk(sigmoidf_(v1[2]), sigmoidf_(v1[3]));
                        *(u32x4*)(gp + bj * 128) = w;
                    }
                }
        } else {
#pragma unroll
            for (int ai = 0; ai < 2; ++ai) {
                u32x4 gq[4][2], mq[4][2];
#pragma unroll
                for (int m = 0; m < 4; ++m) { const bf16_t* rp = act + (size_t)(row0 + ai * 128 + m * 16) * PITCH + col0;
#pragma unroll
                    for (int bj = 0; bj < 2; ++bj) { gq[m][bj] = *(const u32x4*)(rp + C_GS + bj * 128); if (z > 1) mq[m][bj] = *(const u32x4*)(rp + C_MERGED + bj * 128); } }
#pragma unroll
                for (int m = 0; m < 4; ++m) { bf16_t* mp = act + (size_t)(row0 + ai * 128 + m * 16) * PITCH + C_MERGED + col0;
#pragma unroll
                    for (int bj = 0; bj < 2; ++bj) {
                        const u32x4 g = gq[m][bj];
                        const f32x4 a0 = acc[ai][bj][m][0], a1 = acc[ai][bj][m][1];
                        float r0 = bflo(g.x) * a0[0], r1 = bfhi(g.x) * a0[1], r2 = bflo(g.y) * a0[2], r3 = bfhi(g.y) * a0[3];
                        float r4 = bflo(g.z) * a1[0], r5 = bfhi(g.z) * a1[1], r6 = bflo(g.w) * a1[2], r7 = bfhi(g.w) * a1[3];
                        if (z > 1) { const u32x4 pm_ = mq[m][bj];
                            r0 += bflo(pm_.x); r1 += bfhi(pm_.x); r2 += bflo(pm_.y); r3 += bfhi(pm_.y); r4 += bflo(pm_.z); r5 += bfhi(pm_.z); r6 += bflo(pm_.w); r7 += bfhi(pm_.w); }
                        u32x4 w; w.x = cvtpk(r0, r1); w.y = cvtpk(r2, r3); w.z = cvtpk(r4, r5); w.w = cvtpk(r6, r7);
                        *(u32x4*)(mp + bj * 128) = w;
                    } }
            }
        }
    }
};
struct EpiOut {
    const float* resid; float* out; bf16_t* act; float* ssq; bool last;
    DI void operator()(f32x4 (&acc)[2][2][4][2], const pg8::GUnit& u, int wr, int wc, int fr, int fq) const {
        const int row0 = u.pm * 256 + wr * 64 + fr; const int col0 = u.pn * 256 + wc * 32 + 8 * fq;
#pragma unroll
        for (int ai = 0; ai < 2; ++ai)
#pragma unroll
            for (int m = 0; m < 4; ++m) {
                const int row = row0 + ai * 128 + m * 16;
                const size_t off = (size_t)row * DM + col0;
                float q = 0.f;
#pragma unroll
                for (int bj = 0; bj < 2; ++bj) {
                    const f32x4 b0 = *(const f32x4*)(resid + off + bj * 128), b1 = *(const f32x4*)(resid + off + bj * 128 + 4);
                    const f32x4 v0 = b0 + acc[ai][bj][m][0], v1 = b1 + acc[ai][bj][m][1];
                    *(f32x4*)(out + off + bj * 128) = v0; *(f32x4*)(out + off + bj * 128 + 4) = v1;
                    q += (v0[0] * v0[0] + v0[1] * v0[1]) + (v0[2] * v0[2] + v0[3] * v0[3]) + (v1[0] * v1[0] + v1[1] * v1[1]) + (v1[2] * v1[2] + v1[3] * v1[3]);
                    if (!last) { u32x4 w; w.x = cvtpk(v0[0], v0[1]); w.y = cvtpk(v0[2], v0[3]); w.z = cvtpk(v1[0], v1[1]); w.w = cvtpk(v1[2], v1[3]);
                        *(u32x4*)(act + (size_t)row * PITCH + XB_COL + col0 + bj * 128) = w; }
                }
                q += __shfl_xor(q, 16); q += __shfl_xor(q, 32);
                if (fq == 0) ssq[(size_t)row * 16 + u.pn * 4 + wc] = q;
            }
    }
};

struct TrItem { const float* W; bf16_t* WT; const float* ks; int N, ldwt, item; };
DI void tr_load(f32x4 (&v)[8], float (&sc)[8], const TrItem& t, int lane) {
    const int nblk = t.N / 32, kb = t.item / nblk, nb = t.item % nblk, k0 = 64 * kb, n0 = 32 * nb;
#pragma unroll
    for (int i = 0; i < 8; ++i) { const int kk = 8 * i + (lane >> 3), nn = (lane & 7) * 4; v[i] = *(const f32x4*)(t.W + (size_t)(k0 + kk) * t.N + n0 + nn); sc[i] = t.ks ? t.ks[k0 + kk] : 1.0f; }
}
DI void tr_finish(const f32x4 (&v)[8], const float (&sc)[8], const TrItem& t, LAS float* scr, int lane) {
    const int nblk = t.N / 32, kb = t.item / nblk, nb = t.item % nblk, k0 = 64 * kb, n0 = 32 * nb;
#pragma unroll
    for (int i = 0; i < 8; ++i) { const int kk = 8 * i + (lane >> 3), nn = (lane & 7) * 4; const f32x4 w = v[i] * sc[i];
        LAS float* d = scr + kk * 33 + nn; d[0] = w.x; d[1] = w.y; d[2] = w.z; d[3] = w.w; }
    asm volatile("s_waitcnt lgkmcnt(0)" ::: "memory");
    const int c = lane & 7;
#pragma unroll
    for (int j = 0; j < 4; ++j) { const int n = (lane >> 3) + 8 * j; const LAS float* s = scr + (8 * c) * 33 + n;
        u32x4 o; o.x = cvtpk(s[0 * 33], s[1 * 33]); o.y = cvtpk(s[2 * 33], s[3 * 33]); o.z = cvtpk(s[4 * 33], s[5 * 33]); o.w = cvtpk(s[6 * 33], s[7 * 33]);
        *(u32x4*)(t.WT + (size_t)(n0 + n) * t.ldwt + k0 + 8 * c) = o; }
    asm volatile("s_waitcnt lgkmcnt(0)" ::: "memory");
}

#define MFMA32(a, b, c) __builtin_amdgcn_mfma_f32_32x32x16_bf16((a), (b), (c), 0, 0, 0)
typedef short v4i16_t __attribute__((ext_vector_type(4)));
DI s16x4 vtr(LAS const unsigned char* p) { return __builtin_bit_cast(s16x4, __builtin_amdgcn_ds_read_tr16_b64_v4i16((LAS v4i16_t*)p)); }
DI bf16x8 pack8(const f32x16& x, const int s) {
    u32x4 p; p.x = cvtpk(x[8 * s], x[8 * s + 1]); p.y = cvtpk(x[8 * s + 2], x[8 * s + 3]); p.z = cvtpk(x[8 * s + 4], x[8 * s + 5]); p.w = cvtpk(x[8 * s + 6], x[8 * s + 7]);
    return __builtin_bit_cast(bf16x8, p);
}
DI void qk_tile(f32x16& p0, f32x16& p1, LAS const unsigned char* Ks, const bf16x8 (&qf)[4], int r, int h) {
#pragma unroll
    for (int s = 0; s < 4; ++s) {
        const bf16x8 k0 = *(LAS const bf16x8*)(Ks + (2 * s + h) * 1024 + r * 16);
        const bf16x8 k1 = *(LAS const bf16x8*)(Ks + (2 * s + h) * 1024 + 512 + r * 16);
        p0 = MFMA32(k0, qf[s], p0); p1 = MFMA32(k1, qf[s], p1);
    }
}
DI void pv_tile(f32x16& o0, f32x16& o1, LAS const unsigned char* Vs, const f32x16& p0, const f32x16& p1, int lane) {
    const int h = lane >> 5;
    LAS const unsigned char* vb = Vs + (4 * h + ((lane & 15) >> 2)) * 64 + ((lane >> 4) & 1) * 32 + (lane & 3) * 8;
#pragma unroll
    for (int kh = 0; kh < 2; ++kh)
#pragma unroll
        for (int s2 = 0; s2 < 2; ++s2) {
            const bf16x8 pb = kh ? pack8(p1, s2) : pack8(p0, s2);
            const int ro = (32 * kh + 16 * s2) * 64;
            const s16x4 l0 = vtr(vb + ro), h0 = vtr(vb + ro + 512), l1 = vtr(vb + 4096 + ro), h1 = vtr(vb + 4096 + ro + 512);
            const bf16x8 v0 = (bf16x8){l0[0], l0[1], l0[2], l0[3], h0[0], h0[1], h0[2], h0[3]};
            const bf16x8 v1 = (bf16x8){l1[0], l1[1], l1[2], l1[3], h1[0], h1[1], h1[2], h1[3]};
            o0 = MFMA32(v0, pb, o0); o1 = MFMA32(v1, pb, o1);
        }
}
DI float xhalf_max(float m) { auto rr = __builtin_amdgcn_permlane32_swap(__float_as_uint(m), __float_as_uint(m), false, false); return fmaxf(__uint_as_float(rr[0]), __uint_as_float(rr[1])); }
DI float xhalf_sum(float v) { auto rr = __builtin_amdgcn_permlane32_swap(__float_as_uint(v), __float_as_uint(v), false, false); return __uint_as_float(rr[0]) + __uint_as_float(rr[1]); }
DI float xhalf_other(float v) { const unsigned b = __float_as_uint(v); auto rr = __builtin_amdgcn_permlane32_swap(b, b, false, false); return __uint_as_float(rr[0] ^ rr[1] ^ b); }
DI void store_pair16(bf16_t* base32, u32x2 wa, u32x2 wb, int k, int h) {
    auto rx = __builtin_amdgcn_permlane32_swap(wa.x, wb.x, false, false);
    auto ry = __builtin_amdgcn_permlane32_swap(wa.y, wb.y, false, false);
    u32x4 w; w.x = rx[0]; w.y = ry[0]; w.z = rx[1]; w.w = ry[1];
    *(u32x4*)(base32 + 8 * (2 * k + h)) = w;
}
DI float silu_(float g) { return g * fast_rcp(1.f + fast_exp2(-g * LOG2E)); }
DI void write_y(const f32x16& o0, const f32x16& o1, float scale, const bf16_t* grow, bf16_t* yrow, int h) {
#pragma unroll
    for (int dh = 0; dh < 2; ++dh) {
        u32x2 w[4];
#pragma unroll
        for (int grp = 0; grp < 4; ++grp) {
            const int d0 = 32 * dh + 8 * grp + 4 * h;
            const u32x2 g = *(const u32x2*)(grow + d0);
            const f32x16& o = dh ? o1 : o0;
            const float y0 = o[4 * grp + 0] * scale * silu_(bflo(g.x)), y1 = o[4 * grp + 1] * scale * silu_(bfhi(g.x));
            const float y2 = o[4 * grp + 2] * scale * silu_(bflo(g.y)), y3 = o[4 * grp + 3] * scale * silu_(bfhi(g.y));
            w[grp].x = cvtpk(y0, y1); w[grp].y = cvtpk(y2, y3);
        }
        store_pair16(yrow + 32 * dh, w[0], w[1], 0, h);
        store_pair16(yrow + 32 * dh, w[2], w[3], 1, h);
    }
}
DI void load_q(bf16x8 (&qf)[4], const bf16_t* qrow, int h) {
#pragma unroll
    for (int s = 0; s < 4; ++s) qf[s] = *(const bf16x8*)(qrow + 16 * s + 8 * h);
}

DI void coop_load_tiles(const bf16_t* kbase, int vdelta, int t_hi, int nt, LAS unsigned char* lds, int wid, int lane) {
#pragma unroll 1
    for (int s0 = 0; s0 < nt; s0 += 4) {
        u32x4 kr[4], vr[4];
#pragma unroll
        for (int s = 0; s < 4; ++s) if (s0 + s < nt) { const bf16_t* src = kbase + (size_t)((t_hi - s0 - s) * 64 + lane) * PITCH + 8 * wid; kr[s] = *(const u32x4*)src; vr[s] = *(const u32x4*)(src + vdelta); }
#pragma unroll
        for (int s = 0; s < 4; ++s) if (s0 + s < nt) { *(LAS u32x4*)(lds + (s0 + s) * 16384 + wid * 1024 + lane * 16) = kr[s];
            *(LAS u32x4*)(lds + (s0 + s) * 16384 + 8192 + (wid >> 2) * 4096 + lane * 64 + (wid & 3) * 16) = vr[s]; }
    }
}
DI void sb_wg_unit(bf16_t* act, int b, int hh, int Qb, LAS unsigned char* lds, volatile LAS unsigned* ctl, int tid, int wid, int lane) {
    const int r = lane & 31, h = lane >> 5;
    const int Q = Qb * 256, q0 = Q + 32 * wid, qpos = q0 + r;
    const size_t rowq = (size_t)b * SEQ + qpos;
    bf16x8 qf[4]; load_q(qf, act + rowq * PITCH + C_QA + hh * 64, h);
    f32x16 o0, o1;
#pragma unroll
    for (int i = 0; i < 16; ++i) { o0[i] = 0.f; o1[i] = 0.f; }
    float C = 1.f;
    const bf16_t* kgb = act + (size_t)b * SEQ * PITCH + C_KA + hh * 64;
    int t = q0 >> 6;
    bool done = false;
    int t_top = (Q >> 6) + 3;
#pragma unroll 1
    for (;;) {
        const int t_bot = (t_top - 7) > 0 ? (t_top - 7) : 0, nt = t_top - t_bot + 1;
        __syncthreads();
        if (tid == 0) ctl[7] = 0u;
        coop_load_tiles(kgb, C_VA - C_KA, t_top, nt, lds, wid, lane);
        __syncthreads();
#pragma unroll 1
        while (!done && t >= t_bot) {
            const int kv0 = t * 64;
            LAS const unsigned char* Ks = lds + (t_top - t) * 16384; LAS const unsigned char* Vs = Ks + 8192;
            f32x16 p0, p1;
#pragma unroll
            for (int i = 0; i < 16; ++i) { p0[i] = 0.f; p1[i] = 0.f; }
            qk_tile(p0, p1, Ks, qf, r, h);
            const bool diag = (kv0 + 63 >= q0);
            f32x16 F0, F1;
#pragma unroll
            for (int i = 0; i < 16; ++i) {
                const int kl = (i & 3) + 8 * (i >> 2) + 4 * h;
                { const float e = fast_exp2(fminf(p0[i], 60.f)); const float f = fast_rcp(1.f + e);
                  const bool valid = !diag || (kv0 + kl < qpos); F0[i] = valid ? f : 1.f; p0[i] = valid ? e * f : 0.f; }
                { const float e = fast_exp2(fminf(p1[i], 60.f)); const float f = fast_rcp(1.f + e);
                  const bool valid = !diag || (kv0 + 32 + kl < qpos); F1[i] = valid ? f : 1.f; p1[i] = valid ? e * f : 0.f; }
            }
            float G[8], Go[8];
#pragma unroll
            for (int g = 0; g < 4; ++g) { G[g] = (F0[4 * g] * F0[4 * g + 1]) * (F0[4 * g + 2] * F0[4 * g + 3]); G[4 + g] = (F1[4 * g] * F1[4 * g + 1]) * (F1[4 * g + 2] * F1[4 * g + 3]); }
#pragma unroll
            for (int g = 0; g < 8; ++g) Go[g] = xhalf_other(G[g]);
            float run = C; float A[8];
#pragma unroll
            for (int g = 7; g >= 0; --g) { A[g] = run * (h == 0 ? Go[g] : 1.f); run *= (G[g] * Go[g]); }
#pragma unroll
            for (int g = 0; g < 4; ++g) {
                { float bt = A[g]; p0[4 * g + 3] *= bt; bt *= F0[4 * g + 3]; p0[4 * g + 2] *= bt; bt *= F0[4 * g + 2]; p0[4 * g + 1] *= bt; bt *= F0[4 * g + 1]; p0[4 * g] *= bt; }
                { float bt = A[4 + g]; p1[4 * g + 3] *= bt; bt *= F1[4 * g + 3]; p1[4 * g + 2] *= bt; bt *= F1[4 * g + 2]; p1[4 * g + 1] *= bt; bt *= F1[4 * g + 1]; p1[4 * g] *= bt; }
            }
            C = run;
            pv_tile(o0, o1, Vs, p0, p1, lane);
            if (__all(C < 1.17549435e-38f)) done = true;
            --t;
        }
        if (t < 0) done = true;
        if (!done && lane == 0) ctl[7] = 1u;
        __syncthreads();
        if (ctl[7] == 0u) break;
        t_top = t_bot - 1;
    }
    write_y(o0, o1, 1.0f, act + rowq * PITCH + C_GA + hh * 64, act + rowq * PITCH + C_QA + hh * 64, h);
}
DI void swa_wg_unit(bf16_t* act, int b, int hk, int Qb, const float* sinks_l, LAS const float* tabS, LAS unsigned char* lds, int wid, int lane) {
    const int r = lane & 31, h = lane >> 5;
    const int Q = Qb * 256, q0 = Q + 32 * wid, qpos = q0 + r;
    const size_t rowq = (size_t)b * SEQ + qpos;
    const int t_hi = (Q >> 6) + 3, t_lo = (Q >= 128) ? ((Q - 128) >> 6) : 0;
    __syncthreads();
    coop_load_tiles(act + (size_t)b * SEQ * PITCH + C_KC + hk * 64, C_VC - C_KC, t_hi, t_hi - t_lo + 1, lds, wid, lane);
    __syncthreads();
    const int tlo = (q0 >= 127) ? ((q0 - 127) >> 6) : 0;
#pragma unroll 1
    for (int g = 0; g < 4; ++g) {
        const int hq = 4 * hk + g;
        LAS const float* tab = tabS + hq * 128;
        bf16x8 qf[4]; load_q(qf, act + rowq * PITCH + C_QC + hq * 64, h);
        f32x16 o0, o1;
#pragma unroll
        for (int i = 0; i < 16; ++i) { o0[i] = 0.f; o1[i] = 0.f; }
        float m = sinks_l[hq] * LOG2E, l = (h == 0) ? 1.0f : 0.f;
        for (int t = tlo; t <= (q0 >> 6); ++t) {
            const int kv0 = t * 64;
            LAS const unsigned char* Ks = lds + (t_hi - t) * 16384; LAS const unsigned char* Vs = Ks + 8192;
            f32x16 p0, p1;
#pragma unroll
            for (int i = 0; i < 16; ++i) { p0[i] = 0.f; p1[i] = 0.f; }
            qk_tile(p0, p1, Ks, qf, r, h);
            const int dq = qpos - kv0 - 4 * h;
            float tmax = NEG_INF;
#pragma unroll
            for (int half = 0; half < 2; ++half) {
                float tb[16];
#pragma unroll
                for (int i = 0; i < 16; ++i) { const int d = dq - 32 * half - ((i & 3) + 8 * (i >> 2)); tb[i] = tab[d < 0 ? 0 : (d > 127 ? 127 : d)]; }
#pragma unroll
                for (int i = 0; i < 16; ++i) asm volatile("" : "+v"(tb[i]));
#pragma unroll
                for (int i = 0; i < 16; ++i) { const int d = dq - 32 * half - ((i & 3) + 8 * (i >> 2)); const bool valid = (unsigned)d < 128u;
                    if (half == 0) { p0[i] = valid ? p0[i] + tb[i] : NEG_INF; tmax = fmaxf(tmax, p0[i]); } else { p1[i] = valid ? p1[i] + tb[i] : NEG_INF; tmax = fmaxf(tmax, p1[i]); } }
            }
            tmax = xhalf_max(tmax);
            const bool grow = (tmax - m) > 16.f;
            if (__ballot(grow) != 0ull) {
                const float mn = grow ? tmax : m, alpha = fast_exp2(m - mn);
                l *= alpha; m = mn;
#pragma unroll
                for (int i = 0; i < 16; ++i) { o0[i] *= alpha; o1[i] *= alpha; }
            }
            float ls = 0.f;
#pragma unroll
            for (int i = 0; i < 16; ++i) { p0[i] = fast_exp2(p0[i] - m); p1[i] = fast_exp2(p1[i] - m); ls += p0[i] + p1[i]; }
            l += ls;
            pv_tile(o0, o1, Vs, p0, p1, lane);
        }
        l = xhalf_sum(l);
        write_y(o0, o1, fast_rcp(l), act + rowq * PITCH + C_GC + hq * 64, act + rowq * PITCH + C_QC + hq * 64, h);
    }
}

DI void moba_kmean_frags(bf16x8 (&khi)[4], bf16x8 (&klo)[4], const float* kpart, int b, int hh, int lane) {
    const int r = lane & 31, h = lane >> 5;
    const float* kp = kpart + ((size_t)(b * 32 + r) * 2) * 512 + hh * 64;
    f32x4 a0[4], a1[4], b0[4], b1[4];
#pragma unroll
    for (int s = 0; s < 4; ++s) { const int d = 16 * s + 8 * h; a0[s] = *(const f32x4*)(kp + d); a1[s] = *(const f32x4*)(kp + d + 4); b0[s] = *(const f32x4*)(kp + 512 + d); b1[s] = *(const f32x4*)(kp + 512 + d + 4); }
#pragma unroll
    for (int s = 0; s < 4; ++s) {
        float km[8];
#pragma unroll
        for (int j = 0; j < 4; ++j) { km[j] = (a0[s][j] + b0[s][j]) * (1.0f / 256.0f); km[4 + j] = (a1[s][j] + b1[s][j]) * (1.0f / 256.0f); }
        u32x4 hi4, lo4;
        hi4.x = cvtpk(km[0], km[1]); hi4.y = cvtpk(km[2], km[3]); hi4.z = cvtpk(km[4], km[5]); hi4.w = cvtpk(km[6], km[7]);
        lo4.x = cvtpk(km[0] - bflo(hi4.x), km[1] - bfhi(hi4.x)); lo4.y = cvtpk(km[2] - bflo(hi4.y), km[3] - bfhi(hi4.y));
        lo4.z = cvtpk(km[4] - bflo(hi4.z), km[5] - bfhi(hi4.z)); lo4.w = cvtpk(km[6] - bflo(hi4.w), km[7] - bfhi(hi4.w));
        khi[s] = __builtin_bit_cast(bf16x8, hi4); klo[s] = __builtin_bit_cast(bf16x8, lo4);
    }
}
DI void moba_sel_core(const bf16x8 (&qf)[4], const bf16x8 (&khi)[4], const bf16x8 (&klo)[4], unsigned* sel, int b, int hh, int q0, int lane) {
    const int r = lane & 31, h = lane >> 5;
    const int qpos = q0 + r, own = q0 >> 8;
    unsigned smask = 0u;
    f32x16 g;
#pragma unroll
    for (int i = 0; i < 16; ++i) g[i] = 0.f;
#pragma unroll
    for (int s = 0; s < 4; ++s) { g = MFMA32(khi[s], qf[s], g); g = MFMA32(klo[s], qf[s], g); }
    float gv[16];
#pragma unroll
    for (int i = 0; i < 16; ++i) { const int j = (i & 3) + 8 * (i >> 2) + 4 * h; gv[i] = (j < own) ? g[i] : NEG_INF; }
#pragma unroll
    for (int it = 0; it < 3; ++it) {
        float bv = NEG_INF; int bj = 64;
#pragma unroll
        for (int i = 0; i < 16; ++i) { const int j = (i & 3) + 8 * (i >> 2) + 4 * h; if (gv[i] > bv) { bv = gv[i]; bj = j; } }
        const float ov = __shfl_xor(bv, 32); const int oj = __shfl_xor(bj, 32);
        const bool mine = (bv > ov) || (bv == ov && bj < oj);
        const float wv = mine ? bv : ov; const int wj = mine ? bj : oj;
        if (wv > NEG_INF) smask |= (1u << wj);
#pragma unroll
        for (int i = 0; i < 16; ++i) { const int j = (i & 3) + 8 * (i >> 2) + 4 * h; if (mine && j == bj) gv[i] = NEG_INF; }
    }
    if (h == 0) sel[(size_t)(b * 8 + hh) * SEQ + qpos] = smask;
}
DI void moba_sel_quad(const bf16_t* act, const bf16x8 (&khi)[4], const bf16x8 (&klo)[4], unsigned* sel, int b, int hh, int q0, int lane) {
    const int r = lane & 31, h = lane >> 5;
    bf16x8 q0f[4], q1f[4], q2f[4], q3f[4];
    const bf16_t* base = act + ((size_t)b * SEQ + q0 + r) * PITCH + C_QB + hh * 64;
    load_q(q0f, base, h); load_q(q1f, base + (size_t)32 * PITCH, h); load_q(q2f, base + (size_t)64 * PITCH, h); load_q(q3f, base + (size_t)96 * PITCH, h);
    moba_sel_core(q0f, khi, klo, sel, b, hh, q0, lane);
    moba_sel_core(q1f, khi, klo, sel, b, hh, q0 + 32, lane);
    moba_sel_core(q2f, khi, klo, sel, b, hh, q0 + 64, lane);
    moba_sel_core(q3f, khi, klo, sel, b, hh, q0 + 96, lane);
}
DI void moba_qk(f32x16& p0, f32x16& p1, float ci, LAS const unsigned char* Kt, const bf16x8 (&qf)[4], int r, int h) {
#pragma unroll
    for (int i = 0; i < 16; ++i) { p0[i] = ci; p1[i] = ci; }
    qk_tile(p0, p1, Kt, qf, r, h);
}
DI void moba_softpv(f32x16& c0, f32x16& c1, f32x16& n0, f32x16& n1, bool has_next, bool first, int qpos, int kv0, float& m, float& l, f32x16& o0, f32x16& o1,
                    float bfar, LAS const float* tab, LAS const unsigned char* Vt, int lane) {
    const int h = lane >> 5;
    if (__ballot((qpos - (kv0 + 63)) < 128) != 0ull) {
        const int dq = qpos - kv0 - 4 * h;
#pragma unroll
        for (int half = 0; half < 2; ++half) {
            float tb[16];
#pragma unroll
            for (int i = 0; i < 16; ++i) { const int d = dq - 32 * half - ((i & 3) + 8 * (i >> 2)); tb[i] = tab[d < 0 ? 0 : (d > 128 ? 128 : d)]; }
#pragma unroll
            for (int i = 0; i < 16; ++i) asm volatile("" : "+v"(tb[i]));
#pragma unroll
            for (int i = 0; i < 16; ++i) { const int d = dq - 32 * half - ((i & 3) + 8 * (i >> 2));
                if (half == 0) c0[i] = (d >= 0) ? c0[i] + (tb[i] - bfar) : NEG_INF; else c1[i] = (d >= 0) ? c1[i] + (tb[i] - bfar) : NEG_INF; }
        }
    }
    float tmax = NEG_INF;
#pragma unroll
    for (int i = 0; i < 16; ++i) tmax = fmaxf(tmax, fmaxf(c0[i], c1[i]));
    tmax = xhalf_max(tmax);
    const bool out_of_band = first ? (fabsf(tmax) > 16.f && tmax > -1e30f) : (tmax > 16.f);
    if (__ballot(out_of_band) != 0ull) {
        const float dl = out_of_band ? tmax : 0.f, alpha = first ? 1.0f : fast_exp2(-dl);
        m += dl; l *= alpha;
#pragma unroll
        for (int i = 0; i < 16; ++i) { c0[i] -= dl; c1[i] -= dl; o0[i] *= alpha; o1[i] *= alpha; }
        if (has_next) {
#pragma unroll
            for (int i = 0; i < 16; ++i) { n0[i] -= dl; n1[i] -= dl; }
        }
    }
    float ls = 0.f;
#pragma unroll
    for (int i = 0; i < 16; ++i) { c0[i] = fast_exp2(c0[i]); c1[i] = fast_exp2(c1[i]); ls += c0[i] + c1[i]; }
    l += ls;
    pv_tile(o0, o1, Vt, c0, c1, lane);
}
DI void moba_group(bf16_t* act, float* ml, int b, int hh, int j, int qpos, int slot, const bf16x8 (&qf)[4], bool live, bool isdiag, int ntiles, LAS const float* tab, LAS const unsigned char* lds, int lane) {
    const int r = lane & 31, h = lane >> 5;
    const size_t rowq = (size_t)b * SEQ + qpos;
    f32x16 o0, o1;
#pragma unroll
    for (int i = 0; i < 16; ++i) { o0[i] = 0.f; o1[i] = 0.f; }
    float m = 0.f, l = 0.f;
    const float bfar = tab[128];
    const int kvb = j * 256;
    LAS const unsigned char* Vb = lds + 32768;
    f32x16 a0, a1, b0, b1;
    moba_qk(a0, a1, bfar, lds, qf, r, h);
    if (ntiles > 1) moba_qk(b0, b1, bfar, lds + 8192, qf, r, h);
    moba_softpv(a0, a1, b0, b1, ntiles > 1, true, qpos, kvb, m, l, o0, o1, bfar, tab, Vb, lane);
    if (ntiles > 1) {
        if (ntiles > 2) moba_qk(a0, a1, bfar - m, lds + 2 * 8192, qf, r, h);
        moba_softpv(b0, b1, a0, a1, ntiles > 2, false, qpos, kvb + 64, m, l, o0, o1, bfar, tab, Vb + 8192, lane);
        if (ntiles > 2) {
            if (ntiles > 3) moba_qk(b0, b1, bfar - m, lds + 3 * 8192, qf, r, h);
            moba_softpv(a0, a1, b0, b1, ntiles > 3, false, qpos, kvb + 128, m, l, o0, o1, bfar, tab, Vb + 2 * 8192, lane);
            if (ntiles > 3) moba_softpv(b0, b1, a0, a1, false, false, qpos, kvb + 192, m, l, o0, o1, bfar, tab, Vb + 3 * 8192, lane);
        }
    }
    l = xhalf_sum(l);
    const float inv = fast_rcp(l);
    u32x4 wq[2][2];
#pragma unroll
    for (int dh = 0; dh < 2; ++dh) {
        const f32x16& o = dh ? o1 : o0;
        u32x2 w[4];
#pragma unroll
        for (int grp = 0; grp < 4; ++grp) { w[grp].x = cvtpk(o[4 * grp] * inv, o[4 * grp + 1] * inv); w[grp].y = cvtpk(o[4 * grp + 2] * inv, o[4 * grp + 3] * inv); }
#pragma unroll
        for (int k = 0; k < 2; ++k) {
            auto rx = __builtin_amdgcn_permlane32_swap(w[2 * k].x, w[2 * k + 1].x, false, false);
            auto ry = __builtin_amdgcn_permlane32_swap(w[2 * k].y, w[2 * k + 1].y, false, false);
            wq[dh][k].x = rx[0]; wq[dh][k].y = ry[0]; wq[dh][k].z = rx[1]; wq[dh][k].w = ry[1];
        }
    }
    if (live) {
        bf16_t* prow = act + rowq * PITCH + (slot < 3 ? (C_KA + (slot * 8 + hh) * 64) : (C_KC + hh * 64));
#pragma unroll
        for (int dh = 0; dh < 2; ++dh)
#pragma unroll
            for (int k = 0; k < 2; ++k) *(u32x4*)(prow + 32 * dh + 8 * (2 * k + h)) = wq[dh][k];

        if (h == 0) { float* mp = ml + ((rowq * 8 + hh) * 4 + slot) * 2; mp[0] = m; mp[1] = l; }
    }
}
struct MobaGrp { int qpos, slot, ntiles; bool live, isdiag; };
DI bool moba_prepare(MobaGrp& G, bf16x8 (&qf)[4], const bf16_t* act, int b, int hh, int j, int total, int g, volatile LAS unsigned short* list, int lane) {
    const int r = lane & 31, h = lane >> 5;
    const int ng = 8 + ((total + 31) >> 5);
    if (g >= ng) return false;
    if (g < 8) { const int slice = 7 - g; G.qpos = j * 256 + slice * 32 + r; G.slot = 3; G.ntiles = (slice >> 1) + 1; G.live = true; G.isdiag = true; }
    else { const int gi = g - 8, idx = gi * 32 + r; G.live = idx < total; const unsigned e = list[G.live ? idx : gi * 32]; G.qpos = (int)(e & 0x1fffu); G.slot = (int)(e >> 13); G.ntiles = 4; G.isdiag = false; }
    load_q(qf, act + ((size_t)b * SEQ + G.qpos) * PITCH + C_QB + hh * 64, h);
    return true;
}
DI void moba_block_phase(bf16_t* act, const unsigned* sel, float* ml, unsigned* qctr, LAS const float* tabM, LAS unsigned char* lds, int tid, int wid, int lane) {
    volatile LAS unsigned* ctl = (volatile LAS unsigned*)(lds + LDS_CTL);
    volatile LAS unsigned short* list = (volatile LAS unsigned short*)(lds + 65536);
    unsigned* gctr = (unsigned*)(LAS unsigned*)(lds + LDS_CTL + 5 * 4);
    if (tid == 0) ctl[6] = __hip_atomic_fetch_add(qctr, 1u, __ATOMIC_RELAXED, __HIP_MEMORY_SCOPE_AGENT);
    for (;;) {
        __syncthreads();
        const unsigned u = ctl[6];
        if (u >= 1024u) break;
        const int j = (int)(u >> 5), bh = (int)(u & 31u), b = bh >> 3, hh = bh & 7;
        const unsigned* selp = sel + (size_t)bh * SEQ;
        const int C = (31 - j) * 32, base = (j + 1) * 256 + wid * C;
        unsigned words[16];
#pragma unroll
        for (int k = 0; k < 16; ++k) { const int idx = k * 64 + lane; const unsigned w = selp[base + (idx < C ? idx : 0)]; words[k] = (idx < C) ? w : 0u; }
        {
            const bf16_t* kb = act + ((size_t)b * SEQ + j * 256 + lane) * PITCH + C_KB + hh * 64 + 8 * wid;
            u32x4 kreg[4], vreg[4];
#pragma unroll
            for (int t = 0; t < 4; ++t) { kreg[t] = *(const u32x4*)(kb + (size_t)t * 64 * PITCH); vreg[t] = *(const u32x4*)(kb + (size_t)t * 64 * PITCH + (C_VB - C_KB)); }
#pragma unroll
            for (int t = 0; t < 4; ++t) { *(LAS u32x4*)(lds + t * 8192 + wid * 1024 + lane * 16) = kreg[t];
                *(LAS u32x4*)(lds + 32768 + t * 8192 + (wid >> 2) * 4096 + lane * 64 + (wid & 3) * 16) = vreg[t]; }
        }
        int cnt = 0;
#pragma unroll
        for (int k = 0; k < 16; ++k) cnt += __popcll(__ballot(((words[k] >> j) & 1u) != 0u));
        if (lane == 0) ctl[8 + wid] = (unsigned)cnt;
        if (tid == 0) ctl[5] = 0u;
        __syncthreads();
        unsigned nxt_unit = 0u;
        if (tid == 0) nxt_unit = __hip_atomic_fetch_add(qctr, 1u, __ATOMIC_RELAXED, __HIP_MEMORY_SCOPE_AGENT);
        int off = 0, total = 0;
#pragma unroll
        for (int w = 0; w < 8; ++w) { const int c = (int)ctl[8 + w]; off += (w < wid) ? c : 0; total += c; }
#pragma unroll
        for (int k = 0; k < 16; ++k) {
            const bool match = ((words[k] >> j) & 1u) != 0u;
            const unsigned long long mask = __ballot(match);
            if (match) list[off + __popcll(mask & ((1ull << lane) - 1ull))] = (unsigned short)((unsigned)(base + k * 64 + lane) | ((unsigned)__popc(words[k] & ((1u << j) - 1u)) << 13));
            off += __popcll(mask);
        }
        __syncthreads();
        LAS const float* tab = tabM + hh * 132;
        MobaGrp Ga; bf16x8 qa[4];
        for (;;) {
            int g = 0; if (lane == 0) g = (int)__hip_atomic_fetch_add(gctr, 1u, __ATOMIC_RELAXED, __HIP_MEMORY_SCOPE_WORKGROUP);
            g = __builtin_amdgcn_readfirstlane(g);
            if (!moba_prepare(Ga, qa, act, b, hh, j, total, g, list, lane)) break;
            moba_group(act, ml, b, hh, j, Ga.qpos, Ga.slot, qa, Ga.live, Ga.isdiag, Ga.ntiles, tab, lds, lane);
        }
        if (tid == 0) ctl[6] = nxt_unit;
    }
}
DI void moba_combine_token(bf16_t* act, const unsigned* sel, const float* ml, int tok, int lane) {
    const int hh = lane >> 3, ch = lane & 7;
    const int b = tok >> 13, qpos = tok & (SEQ - 1);
    bf16_t* rowp = act + (size_t)tok * PITCH;
    const unsigned word = sel[(size_t)(b * 8 + hh) * SEQ + qpos];
    const f32x4* mlp = (const f32x4*)(ml + ((size_t)tok * 8 + hh) * 8);
    const f32x4 a = mlp[0], c = mlp[1];
    const u32x4 v3 = *(const u32x4*)(rowp + C_KC + hh * 64 + ch * 8);
    u32x4 vs[3];
#pragma unroll
    for (int s = 0; s < 3; ++s) vs[s] = *(const u32x4*)(rowp + C_KA + (s * 8 + hh) * 64 + ch * 8);
    const u32x4 g = *(const u32x4*)(rowp + C_GB + hh * 64 + ch * 8);
    const int ns = __popc(word);
    const float m0 = ns > 0 ? a.x : NEG_INF, m1 = ns > 1 ? a.z : NEG_INF, m2 = ns > 2 ? c.x : NEG_INF, m3 = c.z;
    const float M = fmaxf(fmaxf(m0, m1), fmaxf(m2, m3));
    const float w0 = ns > 0 ? a.y * fast_exp2(m0 - M) : 0.f, w1 = ns > 1 ? a.w * fast_exp2(m1 - M) : 0.f, w2 = ns > 2 ? c.y * fast_exp2(m2 - M) : 0.f, w3 = c.w * fast_exp2(m3 - M);
    const float inv = fast_rcp((w0 + w1) + (w2 + w3));
    float acc[8];
    acc[0] = w3 * bflo(v3.x); acc[1] = w3 * bfhi(v3.x); acc[2] = w3 * bflo(v3.y); acc[3] = w3 * bfhi(v3.y); acc[4] = w3 * bflo(v3.z); acc[5] = w3 * bfhi(v3.z); acc[6] = w3 * bflo(v3.w); acc[7] = w3 * bfhi(v3.w);
#pragma unroll
    for (int s = 0; s < 3; ++s) {
        const float w = s == 0 ? w0 : (s == 1 ? w1 : w2);
        const bool use = s < ns;
        u32x4 v = vs[s]; if (!use) v = (u32x4){0u, 0u, 0u, 0u};
        acc[0] += w * bflo(v.x); acc[1] += w * bfhi(v.x); acc[2] += w * bflo(v.y); acc[3] += w * bfhi(v.y); acc[4] += w * bflo(v.z); acc[5] += w * bfhi(v.z); acc[6] += w * bflo(v.w); acc[7] += w * bfhi(v.w);
    }
    u32x4 y;
    y.x = cvtpk(acc[0] * inv * silu_(bflo(g.x)), acc[1] * inv * silu_(bfhi(g.x))); y.y = cvtpk(acc[2] * inv * silu_(bflo(g.y)), acc[3] * inv * silu_(bfhi(g.y)));
    y.z = cvtpk(acc[4] * inv * silu_(bflo(g.z)), acc[5] * inv * silu_(bfhi(g.z))); y.w = cvtpk(acc[6] * inv * silu_(bflo(g.w)), acc[7] * inv * silu_(bfhi(g.w)));
    *(u32x4*)(rowp + C_QB + hh * 64 + ch * 8) = y;
}

__global__ void __launch_bounds__(512, 2) hybrid_fwd(Params p) {
    extern __shared__ __attribute__((aligned(16))) unsigned char lds_raw[];
    cg::grid_group grid = cg::this_grid();
    LAS unsigned char* lds = (LAS unsigned char*)lds_raw;
    const int G = gridDim.x, wg = blockIdx.x;
#define PHASE_VARS \
    int tid = threadIdx.x; asm volatile("" : "+v"(tid)); \
    const int lane = tid & 63, wid = __builtin_amdgcn_readfirstlane(tid >> 6); \
    const int gw = wg * 8 + wid, NGW = G * 8; (void)gw; (void)NGW; (void)lane; \
    size_t zoff_ = 0; asm volatile("" : "+s"(zoff_)); unsigned char* ws = p.ws + zoff_; \
    bf16_t* win = (bf16_t*)(ws + WS_WIN); bf16_t* wp = (bf16_t*)(ws + WS_WP); bf16_t* wo = (bf16_t*)(ws + WS_WO); (void)win; (void)wp; (void)wo; \
    float* ssq = (float*)(ws + WS_SSQ); float* kpart = (float*)(ws + WS_KPART); bf16_t* act = (bf16_t*)(ws + WS_ACT); (void)ssq; (void)kpart; (void)act; \
    LAS float* tabM = (LAS float*)(lds + LDS_TABM); LAS float* tabS = (LAS float*)(lds + LDS_TABS); (void)tabM; (void)tabS;

    if (threadIdx.x < 16) ((LAS unsigned*)(lds + LDS_CTL))[threadIdx.x] = 0u;
    __syncthreads();
    const XcdBarrier xbar = xcd_barrier_post((unsigned*)(p.ws + WS_CTL), (volatile LAS unsigned*)(lds + LDS_CTL));
#define GRID_BAR() xcd_barrier(xbar)
    if (p.sinks[0] > 1.0e30f) grid.sync();
    { PHASE_VARS
    for (int idx = tid; idx < 8 * 129; idx += 512) {
        const int hh = idx / 129, d = idx - hh * 129;
        int bk = d; if (d >= 16) { bk = 16 + (int)(logf((float)d / 16.0f) / 2.0794415416798357f * 16.0f); if (bk > 31) bk = 31; }
        tabM[hh * 132 + d] = p.rel_bias[bk * 16 + hh] * LOG2E;
        if (d < 128) tabS[hh * 128 + d] = p.rel_bias[bk * 16 + 8 + hh] * LOG2E;
    }

    {
        LAS float* scr = (LAS float*)(lds + wid * 16384);
        constexpr int I_IN = (DM / 64) * (DIN / 32), I_P = (512 / 64) * (DM / 32), I_O = (DM / 64) * (DM / 32);
        constexpr int PER_L = I_IN + 3 * I_P + I_O;
        auto decode = [&](int it) {
            TrItem t; const int l = it / PER_L; int rr = it - l * PER_L;
            if (rr < I_IN) { t.W = p.w_in + (size_t)l * DM * DIN; t.N = DIN; t.WT = win + (size_t)l * DIN * DM; t.ldwt = DM; t.ks = p.norm_w + l * DM; t.item = rr; return t; }
            rr -= I_IN;
            if (rr < 3 * I_P) { const int br = rr / I_P; rr -= br * I_P; t.W = (br == 0 ? p.w_pa : br == 1 ? p.w_pb : p.w_pc) + (size_t)l * 512 * DM; t.N = DM;
                t.WT = wp + ((size_t)(l * 3 + br) * 1024) * 1024; t.ldwt = 1024; t.ks = nullptr; t.item = rr; return t; }
            rr -= 3 * I_P;
            t.W = p.w_out + (size_t)l * DM * DM; t.N = DM; t.WT = wo + (size_t)l * DM * DM; t.ldwt = DM; t.ks = nullptr; t.item = rr; return t;
        };
        {
            f32x4 va[8], vb[8]; float sa[8], sb[8];
            int it = gw;
            TrItem ta, tb;
            if (it < DEPTH * PER_L) { ta = decode(it); tr_load(va, sa, ta, lane); }
            while (it < DEPTH * PER_L) {
                const int itn = it + NGW; const bool hn = itn < DEPTH * PER_L;
                if (hn) { tb = decode(itn); tr_load(vb, sb, tb, lane); }
                tr_finish(va, sa, ta, scr, lane);
                if (!hn) break;
                const int itn2 = itn + NGW; const bool hn2 = itn2 < DEPTH * PER_L;
                if (hn2) { ta = decode(itn2); tr_load(va, sa, ta, lane); }
                tr_finish(vb, sb, tb, scr, lane);
                if (!hn2) break;
                it = itn2;
            }
        }
        {
#define XROW_LOAD(V, R) do { _Pragma("unroll") for (int j = 0; j < 4; ++j) V[j] = ((const f32x4*)(p.x + (size_t)(R) * DM) + lane)[64 * j]; } while (0)
#define XROW_DONE(V, R) do { float s_ = 0.f; _Pragma("unroll") for (int j = 0; j < 4; ++j) s_ += (V[j].x * V[j].x + V[j].y * V[j].y) + (V[j].z * V[j].z + V[j].w * V[j].w); \
            s_ = wave_sum(s_); const float rn_ = 1.0f / sqrtf(s_ * (1.0f / DM) + RMS_EPS); \
            u32x2* o8_ = (u32x2*)(act + (size_t)(R) * PITCH + XB_COL) + lane; \
            _Pragma("unroll") for (int j = 0; j < 4; ++j) { u32x2 w_; w_.x = cvtpk(V[j].x * rn_, V[j].y * rn_); w_.y = cvtpk(V[j].z * rn_, V[j].w * rn_); o8_[64 * j] = w_; } \
            if (lane < 16) ssq[(size_t)(R) * 16 + lane] = (lane == 0) ? s_ : 0.f; } while (0)
            f32x4 va[4], vb[4], vc[4];
            const int last = T - 1;
            int r0 = gw;
            XROW_LOAD(va, r0 < T ? r0 : last);
            XROW_LOAD(vb, r0 + NGW < T ? r0 + NGW : last);
            while (r0 < T) {
                XROW_LOAD(vc, r0 + 2 * NGW < T ? r0 + 2 * NGW : last);
                XROW_DONE(va, r0);
                if (r0 + NGW >= T) break;
                XROW_LOAD(va, r0 + 3 * NGW < T ? r0 + 3 * NGW : last);
                XROW_DONE(vb, r0 + NGW);
                if (r0 + 2 * NGW >= T) break;
                XROW_LOAD(vb, r0 + 4 * NGW < T ? r0 + 4 * NGW : last);
                XROW_DONE(vc, r0 + 2 * NGW);
                r0 += 3 * NGW;
            }
#undef XROW_LOAD
#undef XROW_DONE
        }
    }
    }
    GRID_BAR();

#pragma unroll 1
    for (int layer = 0; layer < DEPTH; ++layer) {
        { PHASE_VARS
          const char* win_l = (const char*)(win + (size_t)layer * DIN * DM);
          SchedIn S; S.O.init(T / 256, NU / 256, G, wg); S.act = (const char*)act; S.win = win_l;
          EpiIn E{act, ssq, kpart, layer != 0};
          pg8::gemm_phase<EpiIn, SchedIn>(lds, PITCH, DM, S, E); }
        GRID_BAR();
        {
            PHASE_VARS
            unsigned* sel = (unsigned*)(ws + WS_SEL);
            for (int u4 = gw; u4 < 2048; u4 += NGW) {
                const int hh = (u4 >> 6) & 7, b = u4 >> 9;
                bf16x8 khi[4], klo[4]; moba_kmean_frags(khi, klo, kpart, b, hh, lane);
                moba_sel_quad(act, khi, klo, sel, b, hh, (u4 & 63) * 128, lane);
            }
            volatile LAS unsigned* ctl = (volatile LAS unsigned*)(lds + LDS_CTL);
            for (int u = wg; u < 1024; u += G) {
                const int Qb = u & 31, hh = (u >> 5) & 7, b = u >> 8;
                sb_wg_unit(act, b, hh, Qb, lds, ctl, tid, wid, lane);
            }
            for (int u = wg; u < 256; u += G) {
                const int Qb = u & 31, hk = (u >> 5) & 1, b = u >> 6;
                swa_wg_unit(act, b, hk, Qb, p.sinks + layer * 8, tabS, lds, wid, lane);
            }
        }
        GRID_BAR();
        {
            PHASE_VARS
            moba_block_phase(act, (const unsigned*)(ws + WS_SEL), (float*)(ws + WS_ML), (unsigned*)(ws + WS_CTL) + XCD_BAR_WORDS + layer, tabM, lds, tid, wid, lane);
        }
        GRID_BAR();
        {
            PHASE_VARS
            for (int tok = gw; tok < T; tok += 2 * NGW) {
                moba_combine_token(act, (const unsigned*)(ws + WS_SEL), (const float*)(ws + WS_ML), tok, lane);
                if (tok + NGW < T) moba_combine_token(act, (const unsigned*)(ws + WS_SEL), (const float*)(ws + WS_ML), tok + NGW, lane);
            }
        }
        GRID_BAR();
        { PHASE_VARS
          const char* win_l = (const char*)(win + (size_t)layer * DIN * DM);
          const char* wp_l = (const char*)(wp + (size_t)layer * 3 * 1024 * 1024);
          SchedMerge S; S.O.init(T / 256, DM / 256, G, wg); S.act = (const char*)act; S.win = win_l; S.wp = wp_l;
          EpiMerge E{act, ssq, layer != 0};
          pg8::gemm_phase<EpiMerge, SchedMerge>(lds, PITCH, DM, S, E); }
        GRID_BAR();
        { PHASE_VARS
          const char* wo_l = (const char*)(wo + (size_t)layer * DM * DM);
          SchedOut S; S.O.init(T / 256, DM / 256, G, wg); S.act = (const char*)act; S.wo = wo_l;
          EpiOut E{layer == 0 ? p.x : (const float*)p.out, p.out, act, ssq, layer == DEPTH - 1};
          pg8::gemm_phase<EpiOut, SchedOut>(lds, PITCH, DM, S, E); }
        GRID_BAR();
    }
    PHASE_VARS
    for (int row = gw; row < T; row += 2 * NGW) {
        const int row2 = (row + NGW < T) ? row + NGW : row;
        f32x4* xr = (f32x4*)(p.out + (size_t)row * DM) + lane; f32x4* xr2 = (f32x4*)(p.out + (size_t)row2 * DM) + lane;
        const f32x4* wr_ = (const f32x4*)(p.fnw) + lane;
        f32x4 v[4], v2[4], w[4];
#pragma unroll
        for (int j = 0; j < 4; ++j) { v[j] = xr[64 * j]; v2[j] = xr2[64 * j]; w[j] = wr_[64 * j]; }
        const float rs = row_rstd(ssq, row), rs2 = row_rstd(ssq, row2);
#pragma unroll
        for (int j = 0; j < 4; ++j) { xr[64 * j] = v[j] * rs * w[j]; if (row2 != row) xr2[64 * j] = v2[j] * rs2 * w[j]; }
    }
}

extern "C" void kernel_launch(void* const* d_in, const int* in_sizes, int n_in, void* d_out, int out_size, void* d_ws, size_t ws_size, hipStream_t stream) {
    static int grid = 0;
    if (grid == 0) {
        if (n_in != 10 || in_sizes[0] != T * DM || out_size != T * DM || ws_size < WS_END) { fprintf(stderr, "kernel_launch: unexpected shapes / workspace (%d inputs, ws %zu)\n", n_in, ws_size); grid = -1; return; }
        int dev = 0, cus = 0, per_cu = 0;
        (void)hipGetDevice(&dev);
        (void)hipDeviceGetAttribute(&cus, hipDeviceAttributeMultiprocessorCount, dev);
        if (hipFuncSetAttribute((const void*)hybrid_fwd, hipFuncAttributeMaxDynamicSharedMemorySize, LDS_BYTES) != hipSuccess) { fprintf(stderr, "kernel_launch: hipFuncSetAttribute failed\n"); grid = -1; return; }
        if (hipOccupancyMaxActiveBlocksPerMultiprocessor(&per_cu, (const void*)hybrid_fwd, 512, LDS_BYTES) != hipSuccess || per_cu < 1) { fprintf(stderr, "kernel_launch: occupancy query says %d\n", per_cu); per_cu = 1; }
        (void)hipGetLastError();
        grid = cus * (per_cu > 1 ? 1 : per_cu);
        if (grid <= 0) grid = 256;
    }
    if (grid < 0) return;
    Params p{};
    p.x = (const float*)d_in[0]; p.norm_w = (const float*)d_in[1]; p.w_in = (const float*)d_in[2]; p.w_pa = (const float*)d_in[3]; p.w_pb = (const float*)d_in[4];
    p.w_pc = (const float*)d_in[5]; p.w_out = (const float*)d_in[6]; p.sinks = (const float*)d_in[7]; p.rel_bias = (const float*)d_in[8]; p.fnw = (const float*)d_in[9];
    p.out = (float*)d_out; p.ws = (unsigned char*)d_ws;
    if (hipMemsetAsync((unsigned char*)d_ws + WS_CTL, 0, (size_t)(XCD_BAR_WORDS + 64) * 4, stream) != hipSuccess) { fprintf(stderr, "kernel_launch: hipMemsetAsync of the control words failed\n"); return; }
    void* args[] = {&p};
    hipError_t e = hipLaunchCooperativeKernel((const void*)hybrid_fwd, dim3(grid), dim3(512), args, LDS_BYTES, stream);
    if (e != hipSuccess) fprintf(stderr, "kernel_launch: cooperative launch failed: %s (grid %d)\n", hipGetErrorString(e), grid);
}
```

```cpp
#include <hip/hip_runtime.h>
#include <hip/hip_cooperative_groups.h>
#include <cstdio>
#include <cstdint>
namespace cg = cooperative_groups;

#define LAS __attribute__((address_space(3)))
#define DI __device__ __forceinline__
typedef unsigned short bf16_t;
typedef short bf16x8 __attribute__((ext_vector_type(8)));
typedef short s16x4 __attribute__((ext_vector_type(4)));
typedef float f32x4 __attribute__((ext_vector_type(4)));
typedef float f32x16 __attribute__((ext_vector_type(16)));
typedef unsigned u32x4 __attribute__((ext_vector_type(4)));
typedef unsigned u32x2 __attribute__((ext_vector_type(2)));

constexpr int BATCH = 4, SEQ = 8192, DM = 1024, T = BATCH * SEQ, DEPTH = 2;
constexpr int DIN = 8448, NU = 5376, PITCH = 6400, XB_COL = 5376;
constexpr int C_QA = 0, C_KA = 512, C_VA = 1024, C_GA = 1536, C_QB = 2048, C_KB = 2560, C_VB = 3072, C_GB = 3584, C_QC = 4096, C_KC = 4608, C_VC = 4736, C_GC = 4864;
constexpr int C_MERGED = 512;
constexpr int C_GS = 2560;
constexpr float LOG2E = 1.4426950408889634f;
constexpr float QSCALE = 0.125f * LOG2E;
constexpr float RMS_EPS = 1e-6f;
constexpr float NEG_INF = -__builtin_huge_valf();

constexpr size_t MiB = 1u << 20;
constexpr size_t WS_WIN = 0;
constexpr size_t WS_WP = 33 * MiB;
constexpr size_t WS_WO = 45 * MiB;
constexpr size_t WS_SSQ = 49 * MiB;
constexpr size_t WS_KPART = 51 * MiB;
constexpr size_t WS_ACT = 52 * MiB;
constexpr size_t WS_SEL = 452 * MiB;
constexpr size_t WS_ML = 453 * MiB;
constexpr size_t WS_CTL = 462 * MiB;
constexpr size_t WS_END = 463 * MiB;

constexpr int LDS_MAIN = 131072;
constexpr int LDS_TABM = LDS_MAIN;
constexpr int LDS_TABS = LDS_TABM + 8 * 132 * 4;
constexpr int LDS_CTL = LDS_TABS + 8 * 128 * 4;
constexpr int LDS_BYTES = 143360;

DI unsigned cvtpk(float lo, float hi) { typedef float f2 __attribute__((ext_vector_type(2))); typedef __bf16 b2 __attribute__((ext_vector_type(2))); f2 v = {lo, hi}; b2 b = __builtin_convertvector(v, b2); return __builtin_bit_cast(unsigned, b); }
DI float bf2f(unsigned short b) { return __uint_as_float(((unsigned)b) << 16); }
DI float bflo(unsigned w) { return __uint_as_float(w << 16); }
DI float bfhi(unsigned w) { return __uint_as_float(w & 0xffff0000u); }
DI float wave_sum(float v) {
#pragma unroll
    for (int o = 1; o < 64; o <<= 1) v += __shfl_xor(v, o);
    return v;
}
DI float fast_exp2(float x) { return __builtin_amdgcn_exp2f(x); }
DI float fast_log2(float x) { return __builtin_amdgcn_logf(x); }
DI float fast_rcp(float x) { return __builtin_amdgcn_rcpf(x); }
DI float sigmoidf_(float x) { return fast_rcp(1.f + fast_exp2(-x * LOG2E)); }

#define XB_TMO      128
#define XB_XCNT(j)  (256  + 64 * (j))
#define XB_XSUB(j)  (1280 + 64 * (j))
#define XB_XGEN(j)  (2304 + 64 * (j))
#define XB_TOP      3328
#define XB_TOPGEN   3392
#define XCD_BAR_WORDS 3456
#define XB_SPIN_CAP (1u << 18)
DI unsigned xb_ld(unsigned* p)              { return __hip_atomic_load(p, __ATOMIC_RELAXED, __HIP_MEMORY_SCOPE_AGENT); }
DI unsigned xb_add(unsigned* p, unsigned v) { return __hip_atomic_fetch_add(p, v, __ATOMIC_RELAXED, __HIP_MEMORY_SCOPE_AGENT); }
DI unsigned xb_xcc_id() { return (unsigned)__builtin_amdgcn_s_getreg((3 << 11) | 20) & 0xFu; }
#define XB_SPIN(cond, bar) do { unsigned _sp = 0; while (cond) { __builtin_amdgcn_s_sleep(1); \
    if ((++_sp & 255u) == 0u) { if (xb_ld(&(bar)[XB_TMO])) break; if (_sp > XB_SPIN_CAP) { atomicAdd(&(bar)[XB_TMO], 1u); break; } } } } while (0)
struct XcdBarrier { unsigned* bar; unsigned x; volatile LAS unsigned* st; };
DI XcdBarrier xcd_barrier_post(unsigned* bar, volatile LAS unsigned* st) {
    XcdBarrier b; b.bar = bar; b.x = xb_xcc_id(); b.st = st;
    if (threadIdx.x == 0) (void)xb_add(&bar[XB_XCNT(b.x)], 1u);
    return b;
}
DI void xcd_barrier_complete(unsigned* bar, unsigned x, unsigned& nloc, unsigned& nx) {
    const unsigned G = gridDim.x * gridDim.y * gridDim.z;
    unsigned sum, cnt, mine, sp = 0u;
    for (;;) {
        sum = 0u; cnt = 0u; mine = 0u;
#pragma unroll
        for (unsigned j = 0; j < 16; ++j) { const unsigned c = xb_ld(&bar[XB_XCNT(j)]); sum += c; cnt += (c > 0u) ? 1u : 0u; mine = (j == x) ? c : mine; }
        if (sum == G) break;
        __builtin_amdgcn_s_sleep(1);
        if ((++sp & 255u) == 0u) { if (xb_ld(&bar[XB_TMO])) break; if (sp > XB_SPIN_CAP) { atomicAdd(&bar[XB_TMO], 1u); break; } }
    }
    nloc = mine > 0u ? mine : 1u; nx = cnt > 0u ? cnt : 1u;
}
DI void xcd_barrier(const XcdBarrier& b) {
    asm volatile("s_waitcnt vmcnt(0)" ::: "memory");
    __syncthreads();
    if (threadIdx.x == 0) {
        unsigned* bar = b.bar;
        __builtin_amdgcn_s_waitcnt(0);
        unsigned nloc = b.st[0], nx = b.st[1];
        if (nloc == 0u) { xcd_barrier_complete(bar, b.x, nloc, nx); b.st[0] = nloc; b.st[1] = nx; }
        const unsigned old = xb_add(&bar[XB_XSUB(b.x)], 1u);
        const unsigned gen = old / nloc;
        if (old + 1u == (gen + 1u) * nloc) {
            __builtin_amdgcn_fence(__ATOMIC_RELEASE, "agent");
            asm volatile("s_waitcnt vmcnt(0)" ::: "memory");
            const unsigned og = xb_add(&bar[XB_TOP], 1u);
            const unsigned tg = og / nx;
            if (og + 1u == (tg + 1u) * nx) xb_add(&bar[XB_TOPGEN], 1u);
            else XB_SPIN(xb_ld(&bar[XB_TOPGEN]) == tg, bar);
            __builtin_amdgcn_fence(__ATOMIC_ACQUIRE, "agent");
            xb_add(&bar[XB_XGEN(b.x)], 1u);
            asm volatile("s_waitcnt vmcnt(0)" ::: "memory");
        } else {
            XB_SPIN(xb_ld(&bar[XB_XGEN(b.x)]) == gen, bar);
            __builtin_amdgcn_fence(__ATOMIC_ACQUIRE, "agent");
            asm volatile("s_waitcnt vmcnt(0)" ::: "memory");
        }
    }
    __syncthreads();
}

struct Params {
    const float* x; const float* norm_w; const float* w_in; const float* w_pa; const float* w_pb; const float* w_pc; const float* w_out;
    const float* sinks; const float* rel_bias; const float* fnw; float* out; unsigned char* ws;
};

namespace pg8 {
constexpr int BM = 256, BK = 64, HALF = 128, HTB = HALF * BK * 2, STAGE_BYTES = 8 * HTB, NXCD = 8, WGM = 8;
__host__ __device__ __forceinline__ int lds_byte(int r, int c) { const int st = (r >> 4) * 2 + (c >> 5), rr = r & 15, cc = c & 31, ob = rr * 64 + cc * 2; return st * 1024 + (ob ^ (((ob >> 9) & 1) << 5)); }
__host__ __device__ __forceinline__ void stage_rc(int b, int& R, int& C) { const int st = b / 1024, sb = b % 1024, swz = sb ^ (((sb >> 9) & 1) << 5); R = (st >> 1) * 16 + swz / 64; C = (st & 1) * 32 + (swz % 64) / 2; }
__host__ __device__ __forceinline__ int perm32(int rho) { const int n = rho >> 4, i = rho & 15; return 8 * (i >> 2) + 4 * n + (i & 3); }

struct Tile { int pm, pn; };
struct GUnit { const char* A; const char* B; int nt; int pm, pn, z; };

struct TileOrder {
    int nM, nN, nwg, G, c;
    __device__ void init(int nM_, int nN_, int G_, int c_) { nM = nM_; nN = nN_; nwg = nM * nN; G = G_; c = c_; }
    __device__ bool tile(int i, Tile& u) const {
        const long L = (long)i * G + c; if (L >= nwg) return false;
        int wgid = (int)L; { const int q = nwg / NXCD, r = nwg % NXCD, xcd = wgid % NXCD, off = wgid / NXCD; wgid = (xcd < r ? xcd * (q + 1) : r * (q + 1) + (xcd - r) * q) + off; }
        const int nig = WGM * nN, gid = wgid / nig, fm = gid * WGM, gsz = (nM - fm) < WGM ? (nM - fm) : WGM;
        u.pm = fm + ((wgid % nig) % gsz); u.pn = (wgid % nig) / gsz; return true;
    }
};

template <class Epi, class Sched>
__device__ __forceinline__ void gemm_phase(LAS unsigned char* lds, const int lda, const int ldb, const Sched& S, const Epi& E) {
    int tid = threadIdx.x; asm volatile("" : "+v"(tid));
    const int wid = __builtin_amdgcn_readfirstlane(tid >> 6), lane = tid & 63, wr = wid >> 2, wc = wid & 3, fr = lane & 15, fq = lane >> 4;
    unsigned voffA[2], voffB[2];
#pragma unroll
    for (int i = 0; i < 2; ++i) { int R, C; stage_rc(tid * 16 + i * 8192, R, C); const int Rb = (R & ~31) + perm32(R & 31);
        voffA[i] = (unsigned)(R * lda + C) * 2u; voffB[i] = (unsigned)(Rb * ldb + C) * 2u; }
    const size_t kstep = (size_t)(BK * 2);
    const size_t hstepA = (size_t)HALF * lda * 2, hstepB = (size_t)HALF * ldb * 2;
    const unsigned ldsw = (unsigned)wid * 1024u;
    const int aoff = lds_byte(wr * 64 + fr, fq * 8), boff = lds_byte(wc * 32 + fr, fq * 8);
#define PG8_SA(b, h) (((b) * 2 + (h)) * HTB)
#define PG8_SB(b, h) ((4 + (b) * 2 + (h)) * HTB)
#define PG8_STAGE(bufoff, gbase, voff) do { _Pragma("unroll") for (int _i = 0; _i < 2; ++_i) \
        __builtin_amdgcn_global_load_lds((const unsigned*)((const char*)(gbase) + (voff)[_i]), (LAS unsigned*)(lds + (bufoff) + ldsw + _i * 8192), 16, 0, 0); } while (0)
#define PG8_LDA(dst, b, h) do { _Pragma("unroll") for (int m = 0; m < 4; ++m) _Pragma("unroll") for (int k = 0; k < 2; ++k) dst[m][k] = *(const LAS bf16x8*)(lds + PG8_SA(b, h) + aoff + m * 2048 + k * 1024); } while (0)
#define PG8_LDB(dst, b, h) do { _Pragma("unroll") for (int n = 0; n < 2; ++n) _Pragma("unroll") for (int k = 0; k < 2; ++k) dst[n][k] = *(const LAS bf16x8*)(lds + PG8_SB(b, h) + boff + n * 2048 + k * 1024); } while (0)
#define PG8_MMA(ai, bj, At, Bt) do { __builtin_amdgcn_s_setprio(1); _Pragma("unroll") for (int m = 0; m < 4; ++m) _Pragma("unroll") for (int n = 0; n < 2; ++n) _Pragma("unroll") for (int k = 0; k < 2; ++k) \
        acc[ai][bj][m][n] = __builtin_amdgcn_mfma_f32_16x16x32_bf16(Bt[n][k], At[m][k], acc[ai][bj][m][n], 0, 0, 0); __builtin_amdgcn_s_setprio(0); } while (0)
#define PG8_WAIT_V(n) asm volatile("s_waitcnt vmcnt(" #n ")" ::: "memory")
#define PG8_WAIT_L(n) asm volatile("s_waitcnt lgkmcnt(" #n ")" ::: "memory")
#define PG8_BAR __builtin_amdgcn_s_barrier()
#define PG8_SCHED __builtin_amdgcn_sched_barrier(0)
    GUnit cur, nxt; int ui = 0;
    if (!S.next(0, cur)) return;
    f32x4 acc[2][2][4][2];
#pragma unroll
    for (int a = 0; a < 2; ++a)
#pragma unroll
        for (int b = 0; b < 2; ++b)
#pragma unroll
            for (int m = 0; m < 4; ++m)
#pragma unroll
                for (int n = 0; n < 2; ++n) acc[a][b][m][n] = (f32x4){0.f, 0.f, 0.f, 0.f};
    bf16x8 At[4][2], B0[2][2], B1[2][2];
    const char* cA = cur.A; const char* cB = cur.B;
    PG8_STAGE(PG8_SB(0, 0), cB, voffB); PG8_STAGE(PG8_SB(0, 1), cB + hstepB, voffB); PG8_STAGE(PG8_SA(0, 0), cA, voffA); PG8_STAGE(PG8_SA(0, 1), cA + hstepA, voffA);
    if (wr == 1) PG8_BAR;
    PG8_WAIT_V(2); PG8_BAR;
    PG8_STAGE(PG8_SB(1, 0), cB + kstep, voffB); PG8_STAGE(PG8_SA(1, 0), cA + kstep, voffA); PG8_STAGE(PG8_SB(1, 1), cB + hstepB + kstep, voffB);
    PG8_WAIT_V(6); PG8_BAR;
    for (;;) {
        const bool has_next = S.next(ui + 1, nxt);
        const char* nA = has_next ? nxt.A : cA; const char* nB = has_next ? nxt.B : cB;
        const int nt = cur.nt;
        for (int t = 0; t < nt; t += 2) {
            const bool last = (t == nt - 2);
            const char* a1 = cA + (size_t)(t + 1) * kstep;
            const char* a2 = last ? nA : cA + (size_t)(t + 2) * kstep; const char* b2 = last ? nB : cB + (size_t)(t + 2) * kstep;
            const char* a3 = a2 + kstep; const char* b3 = b2 + kstep;
            PG8_LDB(B0, 0, 0); PG8_LDB(B1, 0, 1); PG8_SCHED; PG8_LDA(At, 0, 0); PG8_STAGE(PG8_SA(1, 1), a1 + hstepA, voffA);
            PG8_WAIT_V(8); PG8_WAIT_L(0); PG8_BAR; PG8_MMA(0, 0, At, B0); PG8_MMA(0, 1, At, B1); PG8_BAR; PG8_SCHED;
            PG8_LDA(At, 0, 1); PG8_STAGE(PG8_SB(0, 0), b2, voffB); PG8_STAGE(PG8_SB(0, 1), b2 + hstepB, voffB); PG8_STAGE(PG8_SA(0, 0), a2, voffA);
            PG8_WAIT_V(8); PG8_WAIT_L(0); PG8_BAR; PG8_MMA(1, 0, At, B0); PG8_MMA(1, 1, At, B1); PG8_BAR; PG8_SCHED;
            PG8_LDB(B0, 1, 0); PG8_LDB(B1, 1, 1); PG8_SCHED; PG8_LDA(At, 1, 0); PG8_STAGE(PG8_SA(0, 1), a2 + hstepA, voffA);
            PG8_WAIT_V(8); PG8_WAIT_L(0); PG8_BAR; PG8_MMA(0, 0, At, B0); PG8_MMA(0, 1, At, B1); PG8_BAR; PG8_SCHED;
            PG8_LDA(At, 1, 1); PG8_STAGE(PG8_SB(1, 0), b3, voffB); PG8_STAGE(PG8_SB(1, 1), b3 + hstepB, voffB); PG8_STAGE(PG8_SA(1, 0), a3, voffA);
            PG8_WAIT_V(8); PG8_WAIT_L(0); PG8_BAR; PG8_MMA(1, 0, At, B0); PG8_MMA(1, 1, At, B1); PG8_BAR; PG8_SCHED;
        }
        if (wr == 0) PG8_BAR;
        E(acc, cur, wr, wc, fr, fq);
        if (!has_next) break;
#pragma unroll
        for (int a = 0; a < 2; ++a)
#pragma unroll
            for (int b = 0; b < 2; ++b)
#pragma unroll
                for (int m = 0; m < 4; ++m)
#pragma unroll
                    for (int n = 0; n < 2; ++n) acc[a][b][m][n] = (f32x4){0.f, 0.f, 0.f, 0.f};
        cur = nxt; cA = nA; cB = nB; ++ui;
        if (wr == 1) PG8_BAR;
    }
    PG8_WAIT_V(0);
    PG8_BAR;
#undef PG8_SA
#undef PG8_SB
#undef PG8_STAGE
#undef PG8_LDA
#undef PG8_LDB
#undef PG8_MMA
#undef PG8_WAIT_V
#undef PG8_WAIT_L
#undef PG8_BAR
#undef PG8_SCHED
}
}

struct SchedIn {
    pg8::TileOrder O; const char* act; const char* win;
    __device__ bool next(int i, pg8::GUnit& u) const { pg8::Tile t; if (!O.tile(i, t)) return false;
        u.pm = t.pm; u.pn = t.pn; u.z = 0; u.nt = 16;
        u.A = act + ((size_t)t.pm * 256 * PITCH + XB_COL) * 2; u.B = win + (size_t)t.pn * 256 * 1024 * 2; return true; }
};
struct SchedMerge {
    pg8::TileOrder O; const char* act; const char* win; const char* wp;
    __device__ bool next(int i, pg8::GUnit& u) const { pg8::Tile t; const int ti = i / 6, z = i - ti * 6; if (!O.tile(ti, t)) return false;
        const int br = z >> 1; u.pm = t.pm; u.pn = t.pn; u.z = z;
        if (z & 1) { u.nt = 8; u.A = act + ((size_t)t.pm * 256 * PITCH + br * 2048) * 2; u.B = wp + ((size_t)(br * 1024 + t.pn * 256) * 1024) * 2; }
        else { u.nt = 16; u.A = act + ((size_t)t.pm * 256 * PITCH + XB_COL) * 2; u.B = win + ((size_t)(NU + br * 1024 + t.pn * 256) * 1024) * 2; }
        return true; }
};
struct SchedOut {
    pg8::TileOrder O; const char* act; const char* wo;
    __device__ bool next(int i, pg8::GUnit& u) const { pg8::Tile t; if (!O.tile(i, t)) return false;
        u.pm = t.pm; u.pn = t.pn; u.z = 0; u.nt = 16;
        u.A = act + ((size_t)t.pm * 256 * PITCH + C_MERGED) * 2; u.B = wo + (size_t)t.pn * 256 * 1024 * 2; return true; }
};

DI float row_rstd(const float* ssq, int row) {
    const f32x4* p = (const f32x4*)(ssq + (size_t)row * 16);
    const f32x4 a = p[0], b = p[1], c = p[2], d = p[3];
    const float s = ((a.x + a.y) + (a.z + a.w)) + ((b.x + b.y) + (b.z + b.w)) + ((c.x + c.y) + (c.z + c.w)) + ((d.x + d.y) + (d.z + d.w));
    return 1.0f / sqrtf(s * (1.0f / DM) + RMS_EPS);
}
DI void rows_rstd8(float (&rs)[2][4], const float* ssq, int row0, int fq) {
    f32x4 part[2][4];
#pragma unroll
    for (int ai = 0; ai < 2; ++ai)
#pragma unroll
        for (int m = 0; m < 4; ++m) part[ai][m] = *(const f32x4*)(ssq + (size_t)(row0 + ai * 128 + m * 16) * 16 + fq * 4);
#pragma unroll
    for (int ai = 0; ai < 2; ++ai)
#pragma unroll
        for (int m = 0; m < 4; ++m) { const f32x4 q = part[ai][m]; float t = (q.x + q.y) + (q.z + q.w); t += __shfl_xor(t, 16); t += __shfl_xor(t, 32);
            rs[ai][m] = 1.0f / sqrtf(t * (1.0f / DM) + RMS_EPS); }
}
struct EpiIn {
    bf16_t* act; const float* ssq; float* kpart; bool use_rs;
    DI void operator()(f32x4 (&acc)[2][2][4][2], const pg8::GUnit& u, int wr, int wc, int fr, int fq) const {
        const int row0 = u.pm * 256 + wr * 64 + fr; const int col0 = u.pn * 256 + wc * 32 + 8 * fq;
        const bool isq = (u.pn < 2) || (u.pn == 8) || (u.pn == 9) || (u.pn == 16) || (u.pn == 17);
        const float sc = isq ? QSCALE : 1.0f;
        const bool iskb = (u.pn == 10) || (u.pn == 11);
        float rs8[2][4];
        if (use_rs) rows_rstd8(rs8, ssq, row0, fq);
        else {
#pragma unroll
            for (int ai = 0; ai < 2; ++ai)
#pragma unroll
                for (int m = 0; m < 4; ++m) rs8[ai][m] = 1.0f;
        }
        f32x4 cs[2][2];
#pragma unroll
        for (int bj = 0; bj < 2; ++bj)
#pragma unroll
            for (int n = 0; n < 2; ++n) cs[bj][n] = (f32x4){0.f, 0.f, 0.f, 0.f};
#pragma unroll
        for (int ai = 0; ai < 2; ++ai)
#pragma unroll
            for (int m = 0; m < 4; ++m) {
                const int row = row0 + ai * 128 + m * 16;
                const float rs = rs8[ai][m] * sc;
                bf16_t* rowp = act + (size_t)row * PITCH + col0;
#pragma unroll
                for (int bj = 0; bj < 2; ++bj) {
                    const f32x4 v0 = acc[ai][bj][m][0] * rs, v1 = acc[ai][bj][m][1] * rs;
                    cs[bj][0] += v0; cs[bj][1] += v1;
                    u32x4 w; w.x = cvtpk(v0[0], v0[1]); w.y = cvtpk(v0[2], v0[3]); w.z = cvtpk(v1[0], v1[1]); w.w = cvtpk(v1[2], v1[3]);
                    *(u32x4*)(rowp + bj * 128) = w;
                }
            }
        if (iskb) {
#pragma unroll
            for (int bj = 0; bj < 2; ++bj)
#pragma unroll
                for (int n = 0; n < 2; ++n)
#pragma unroll
                    for (int j = 0; j < 4; ++j) { float v = cs[bj][n][j]; v += __shfl_xor(v, 1); v += __shfl_xor(v, 2); v += __shfl_xor(v, 4); v += __shfl_xor(v, 8); cs[bj][n][j] = v; }
            if (fr == 0) {
                float* kp = kpart + ((size_t)u.pm * 2 + wr) * 512 + (u.pn - 10) * 256 + wc * 32 + 8 * fq;
#pragma unroll
                for (int bj = 0; bj < 2; ++bj) { *(f32x4*)(kp + bj * 128) = cs[bj][0]; *(f32x4*)(kp + bj * 128 + 4) = cs[bj][1]; }
            }
        }
    }
};
struct EpiMerge {
    bf16_t* act; const float* ssq; bool use_rs;
    DI void operator()(f32x4 (&acc)[2][2][4][2], const pg8::GUnit& u, int wr, int wc, int fr, int fq) const {
        const int row0 = u.pm * 256 + wr * 64 + fr; const int col0 = u.pn * 256 + wc * 32 + 8 * fq;
        const int z = u.z;
        if ((z & 1) == 0) {
            float rs8[2][4];
            if (use_rs) rows_rstd8(rs8, ssq, row0, fq);
            else {
#pragma unroll
                for (int ai = 0; ai < 2; ++ai)
#pragma unroll
                    for (int m = 0; m < 4; ++m) rs8[ai][m] = 1.0f;
            }
#pragma unroll
            for (int ai = 0; ai < 2; ++ai)
#pragma unroll
                for (int m = 0; m < 4; ++m) {
                    bf16_t* gp = act + (size_t)(row0 + ai * 128 + m * 16) * PITCH + C_GS + col0;
                    const float rs = rs8[ai][m];
#pragma unroll
                    for (int bj = 0; bj < 2; ++bj) {
                        const f32x4 v0 = acc[ai][bj][m][0] * rs, v1 = acc[ai][bj][m][1] * rs;
                        u32x4 w; w.x = cvtpk(sigmoidf_(v0[0]), sigmoidf_(v0[1])); w.y = cvtpk(sigmoidf_(v0[2]), sigmoidf_(v0[3]));
                        w.z = cvtpk(sigmoidf_(v1[0]), sigmoidf_(v1[1])); w.w = cvtpk(sigmoidf_(v1[2]), sigmoidf_(v1[3]));
                        *(u32x4*)(gp + bj * 128) = w;
                    }
                }
        } else {
#pragma unroll
            for (int ai = 0; ai < 2; ++ai) {
                u32x4 gq[4][2], mq[4][2];
#pragma unroll
                for (int m = 0; m < 4; ++m) { const bf16_t* rp = act + (size_t)(row0 + ai * 128 + m * 16) * PITCH + col0;
#pragma unroll
                    for (int bj = 0; bj < 2; ++bj) { gq[m][bj] = *(const u32x4*)(rp + C_GS + bj * 128); if (z > 1) mq[m][bj] = *(const u32x4*)(rp + C_MERGED + bj * 128); } }
#pragma unroll
                for (int m = 0; m < 4; ++m) { bf16_t* mp = act + (size_t)(row0 + ai * 128 + m * 16) * PITCH + C_MERGED + col0;
#pragma unroll
                    for (int bj = 0; bj < 2; ++bj) {
                        const u32x4 g = gq[m][bj];
                        const f32x4 a0 = acc[ai][bj][m][0], a1 = acc[ai][bj][m][1];
                        float r0 = bflo(g.x) * a0[0], r1 = bfhi(g.x) * a0[1], r2 = bflo(g.y) * a0[2], r3 = bfhi(g.y) * a0[3];
                        float r4 = bflo(g.z) * a1[0], r5 = bfhi(g.z) * a1[1], r6 = bflo(g.w) * a1[2], r7 = bfhi(g.w) * a1[3];
                        if (z > 1) { const u32x4 pm_ = mq[m][bj];
                            r0 += bflo(pm_.x); r1 += bfhi(pm_.x); r2 += bflo(pm_.y); r3 += bfhi(pm_.y); r4 += bflo(pm_.z); r5 += bfhi(pm_.z); r6 += bflo(pm_.w); r7 += bfhi(pm_.w); }
                        u32x4 w; w.x = cvtpk(r0, r1); w.y = cvtpk(r2, r3); w.z = cvtpk(r4, r5); w.w = cvtpk(r6, r7);
                        *(u32x4*)(mp + bj * 128) = w;
                    } }
            }
        }
    }
};
struct EpiOut {
    const float* resid; float* out; bf16_t* act; float* ssq; bool last;
    DI void operator()(f32x4 (&acc)[2][2][4][2], const pg8::GUnit& u, int wr, int wc, int fr, int fq) const {
        const int row0 = u.pm * 256 + wr * 64 + fr; const int col0 = u.pn * 256 + wc * 32 + 8 * fq;
#pragma unroll
        for (int ai = 0; ai < 2; ++ai)
#pragma unroll
            for (int m = 0; m < 4; ++m) {
                const int row = row0 + ai * 128 + m * 16;
                const size_t off = (size_t)row * DM + col0;
                float q = 0.f;
#pragma unroll
                for (int bj = 0; bj < 2; ++bj) {
                    const f32x4 b0 = *(const f32x4*)(resid + off + bj * 128), b1 = *(const f32x4*)(resid + off + bj * 128 + 4);
                    const f32x4 v0 = b0 + acc[ai][bj][m][0], v1 = b1 + acc[ai][bj][m][1];
                    *(f32x4*)(out + off + bj * 128) = v0; *(f32x4*)(out + off + bj * 128 + 4) = v1;
                    q += (v0[0] * v0[0] + v0[1] * v0[1]) + (v0[2] * v0[2] + v0[3] * v0[3]) + (v1[0] * v1[0] + v1[1] * v1[1]) + (v1[2] * v1[2] + v1[3] * v1[3]);
                    if (!last) { u32x4 w; w.x = cvtpk(v0[0], v0[1]); w.y = cvtpk(v0[2], v0[3]); w.z = cvtpk(v1[0], v1[1]); w.w = cvtpk(v1[2], v1[3]);
                        *(u32x4*)(act + (size_t)row * PITCH + XB_COL + col0 + bj * 128) = w; }
                }
                q += __shfl_xor(q, 16); q += __shfl_xor(q, 32);
                if (fq == 0) ssq[(size_t)row * 16 + u.pn * 4 + wc] = q;
            }
    }
};

struct TrItem { const float* W; bf16_t* WT; const float* ks; int N, ldwt, item; };
DI void tr_load(f32x4 (&v)[8], float (&sc)[8], const TrItem& t, int lane) {
    const int nblk = t.N / 32, kb = t.item / nblk, nb = t.item % nblk, k0 = 64 * kb, n0 = 32 * nb;
#pragma unroll
    for (int i = 0; i < 8; ++i) { const int kk = 8 * i + (lane >> 3), nn = (lane & 7) * 4; v[i] = *(const f32x4*)(t.W + (size_t)(k0 + kk) * t.N + n0 + nn); sc[i] = t.ks ? t.ks[k0 + kk] : 1.0f; }
}
DI void tr_finish(const f32x4 (&v)[8], const float (&sc)[8], const TrItem& t, LAS float* scr, int lane) {
    const int nblk = t.N / 32, kb = t.item / nblk, nb = t.item % nblk, k0 = 64 * kb, n0 = 32 * nb;
#pragma unroll
    for (int i = 0; i < 8; ++i) { const int kk = 8 * i + (lane >> 3), nn = (lane & 7) * 4; const f32x4 w = v[i] * sc[i];
        LAS float* d = scr + kk * 33 + nn; d[0] = w.x; d[1] = w.y; d[2] = w.z; d[3] = w.w; }
    asm volatile("s_waitcnt lgkmcnt(0)" ::: "memory");
    const int c = lane & 7;
#pragma unroll
    for (int j = 0; j < 4; ++j) { const int n = (lane >> 3) + 8 * j; const LAS float* s = scr + (8 * c) * 33 + n;
        u32x4 o; o.x = cvtpk(s[0 * 33], s[1 * 33]); o.y = cvtpk(s[2 * 33], s[3 * 33]); o.z = cvtpk(s[4 * 33], s[5 * 33]); o.w = cvtpk(s[6 * 33], s[7 * 33]);
        *(u32x4*)(t.WT + (size_t)(n0 + n) * t.ldwt + k0 + 8 * c) = o; }
    asm volatile("s_waitcnt lgkmcnt(0)" ::: "memory");
}

DI TrItem tr_decode(const Params& p, bf16_t* win, bf16_t* wp, bf16_t* wo, int it) {
    constexpr int I_IN = (DM / 64) * (DIN / 32), I_P = (512 / 64) * (DM / 32), I_O = (DM / 64) * (DM / 32);
    constexpr int PER_L = I_IN + 3 * I_P + I_O;
    TrItem t; const int l = it / PER_L; int rr = it - l * PER_L;
    if (rr < I_IN) { t.W = p.w_in + (size_t)l * DM * DIN; t.N = DIN; t.WT = win + (size_t)l * DIN * DM; t.ldwt = DM; t.ks = p.norm_w + l * DM; t.item = rr; return t; }
    rr -= I_IN;
    if (rr < 3 * I_P) { const int br = rr / I_P; rr -= br * I_P; t.W = (br == 0 ? p.w_pa : br == 1 ? p.w_pb : p.w_pc) + (size_t)l * 512 * DM; t.N = DM;
        t.WT = wp + ((size_t)(l * 3 + br) * 1024) * 1024; t.ldwt = 1024; t.ks = nullptr; t.item = rr; return t; }
    rr -= 3 * I_P;
    t.W = p.w_out + (size_t)l * DM * DM; t.N = DM; t.WT = wo + (size_t)l * DM * DM; t.ldwt = DM; t.ks = nullptr; t.item = rr; return t;
}
DI void weight_tiles_simple(const Params& p, bf16_t* win, bf16_t* wp, bf16_t* wo, LAS float* scr, int first, int end, int stride, int lane) {
#pragma unroll 1
    for (int it = first; it < end; it += stride) { f32x4 va[8]; float sa[8]; const TrItem ta = tr_decode(p, win, wp, wo, it); tr_load(va, sa, ta, lane); tr_finish(va, sa, ta, scr, lane); }
}

#define MFMA32(a, b, c) __builtin_amdgcn_mfma_f32_32x32x16_bf16((a), (b), (c), 0, 0, 0)
typedef short v4i16_t __attribute__((ext_vector_type(4)));
DI s16x4 vtr(LAS const unsigned char* p) { return __builtin_bit_cast(s16x4, __builtin_amdgcn_ds_read_tr16_b64_v4i16((LAS v4i16_t*)p)); }
DI bf16x8 pack8(const f32x16& x, const int s) {
    u32x4 p; p.x = cvtpk(x[8 * s], x[8 * s + 1]); p.y = cvtpk(x[8 * s + 2], x[8 * s + 3]); p.z = cvtpk(x[8 * s + 4], x[8 * s + 5]); p.w = cvtpk(x[8 * s + 6], x[8 * s + 7]);
    return __builtin_bit_cast(bf16x8, p);
}
DI void qk_tile(f32x16& p0, f32x16& p1, LAS const unsigned char* Ks, const bf16x8 (&qf)[4], int r, int h) {
#pragma unroll
    for (int s = 0; s < 4; ++s) {
        const bf16x8 k0 = *(LAS const bf16x8*)(Ks + (2 * s + h) * 1024 + r * 16);
        const bf16x8 k1 = *(LAS const bf16x8*)(Ks + (2 * s + h) * 1024 + 512 + r * 16);
        p0 = MFMA32(k0, qf[s], p0); p1 = MFMA32(k1, qf[s], p1);
    }
}
DI void pv_tile(f32x16& o0, f32x16& o1, LAS const unsigned char* Vs, const f32x16& p0, const f32x16& p1, int lane) {
    const int h = lane >> 5;
    LAS const unsigned char* vb = Vs + (4 * h + ((lane & 15) >> 2)) * 64 + ((lane >> 4) & 1) * 32 + (lane & 3) * 8;
#pragma unroll
    for (int kh = 0; kh < 2; ++kh)
#pragma unroll
        for (int s2 = 0; s2 < 2; ++s2) {
            const bf16x8 pb = kh ? pack8(p1, s2) : pack8(p0, s2);
            const int ro = (32 * kh + 16 * s2) * 64;
            const s16x4 l0 = vtr(vb + ro), h0 = vtr(vb + ro + 512), l1 = vtr(vb + 4096 + ro), h1 = vtr(vb + 4096 + ro + 512);
            const bf16x8 v0 = (bf16x8){l0[0], l0[1], l0[2], l0[3], h0[0], h0[1], h0[2], h0[3]};
            const bf16x8 v1 = (bf16x8){l1[0], l1[1], l1[2], l1[3], h1[0], h1[1], h1[2], h1[3]};
            o0 = MFMA32(v0, pb, o0); o1 = MFMA32(v1, pb, o1);
        }
}
DI float xhalf_max(float m) { auto rr = __builtin_amdgcn_permlane32_swap(__float_as_uint(m), __float_as_uint(m), false, false); return fmaxf(__uint_as_float(rr[0]), __uint_as_float(rr[1])); }
DI float xhalf_sum(float v) { auto rr = __builtin_amdgcn_permlane32_swap(__float_as_uint(v), __float_as_uint(v), false, false); return __uint_as_float(rr[0]) + __uint_as_float(rr[1]); }
DI float xhalf_other(float v) { const unsigned b = __float_as_uint(v); auto rr = __builtin_amdgcn_permlane32_swap(b, b, false, false); return __uint_as_float(rr[0] ^ rr[1] ^ b); }
DI void store_pair16(bf16_t* base32, u32x2 wa, u32x2 wb, int k, int h) {
    auto rx = __builtin_amdgcn_permlane32_swap(wa.x, wb.x, false, false);
    auto ry = __builtin_amdgcn_permlane32_swap(wa.y, wb.y, false, false);
    u32x4 w; w.x = rx[0]; w.y = ry[0]; w.z = rx[1]; w.w = ry[1];
    *(u32x4*)(base32 + 8 * (2 * k + h)) = w;
}
DI float silu_(float g) { return g * fast_rcp(1.f + fast_exp2(-g * LOG2E)); }
DI void write_y(const f32x16& o0, const f32x16& o1, float scale, const bf16_t* grow, bf16_t* yrow, int h) {
#pragma unroll
    for (int dh = 0; dh < 2; ++dh) {
        u32x2 w[4];
#pragma unroll
        for (int grp = 0; grp < 4; ++grp) {
            const int d0 = 32 * dh + 8 * grp + 4 * h;
            const u32x2 g = *(const u32x2*)(grow + d0);
            const f32x16& o = dh ? o1 : o0;
            const float y0 = o[4 * grp + 0] * scale * silu_(bflo(g.x)), y1 = o[4 * grp + 1] * scale * silu_(bfhi(g.x));
            const float y2 = o[4 * grp + 2] * scale * silu_(bflo(g.y)), y3 = o[4 * grp + 3] * scale * silu_(bfhi(g.y));
            w[grp].x = cvtpk(y0, y1); w[grp].y = cvtpk(y2, y3);
        }
        store_pair16(yrow + 32 * dh, w[0], w[1], 0, h);
        store_pair16(yrow + 32 * dh, w[2], w[3], 1, h);
    }
}
DI void load_q(bf16x8 (&qf)[4], const bf16_t* qrow, int h) {
#pragma unroll
    for (int s = 0; s < 4; ++s) qf[s] = *(const bf16x8*)(qrow + 16 * s + 8 * h);
}

DI void coop_load_tiles(const bf16_t* kbase, int vdelta, int t_hi, int nt, LAS unsigned char* lds, int wid, int lane) {
#pragma unroll 1
    for (int s0 = 0; s0 < nt; s0 += 4) {
        u32x4 kr[4], vr[4];
#pragma unroll
        for (int s = 0; s < 4; ++s) if (s0 + s < nt) { const bf16_t* src = kbase + (size_t)((t_hi - s0 - s) * 64 + lane) * PITCH + 8 * wid; kr[s] = *(const u32x4*)src; vr[s] = *(const u32x4*)(src + vdelta); }
#pragma unroll
        for (int s = 0; s < 4; ++s) if (s0 + s < nt) { *(LAS u32x4*)(lds + (s0 + s) * 16384 + wid * 1024 + lane * 16) = kr[s];
            *(LAS u32x4*)(lds + (s0 + s) * 16384 + 8192 + (wid >> 2) * 4096 + lane * 64 + (wid & 3) * 16) = vr[s]; }
    }
}
DI void sb_wg_unit(bf16_t* act, int b, int hh, int Qb, LAS unsigned char* lds, volatile LAS unsigned* ctl, int tid, int wid, int lane) {
    const int r = lane & 31, h = lane >> 5;
    const int Q = Qb * 256, q0 = Q + 32 * wid, qpos = q0 + r;
    const size_t rowq = (size_t)b * SEQ + qpos;
    bf16x8 qf[4]; load_q(qf, act + rowq * PITCH + C_QA + hh * 64, h);
    f32x16 o0, o1;
#pragma unroll
    for (int i = 0; i < 16; ++i) { o0[i] = 0.f; o1[i] = 0.f; }
    float C = 1.f;
    const bf16_t* kgb = act + (size_t)b * SEQ * PITCH + C_KA + hh * 64;
    int t = q0 >> 6;
    bool done = false;
    int t_top = (Q >> 6) + 3;
#pragma unroll 1
    for (;;) {
        const int t_bot = (t_top - 7) > 0 ? (t_top - 7) : 0, nt = t_top - t_bot + 1;
        __syncthreads();
        if (tid == 0) ctl[7] = 0u;
        coop_load_tiles(kgb, C_VA - C_KA, t_top, nt, lds, wid, lane);
        __syncthreads();
#pragma unroll 1
        while (!done && t >= t_bot) {
            const int kv0 = t * 64;
            LAS const unsigned char* Ks = lds + (t_top - t) * 16384; LAS const unsigned char* Vs = Ks + 8192;
            f32x16 p0, p1;
#pragma unroll
            for (int i = 0; i < 16; ++i) { p0[i] = 0.f; p1[i] = 0.f; }
            qk_tile(p0, p1, Ks, qf, r, h);
            const bool diag = (kv0 + 63 >= q0);
            f32x16 F0, F1;
#pragma unroll
            for (int i = 0; i < 16; ++i) {
                const int kl = (i & 3) + 8 * (i >> 2) + 4 * h;
                { const float e = fast_exp2(fminf(p0[i], 60.f)); const float f = fast_rcp(1.f + e);
                  const bool valid = !diag || (kv0 + kl < qpos); F0[i] = valid ? f : 1.f; p0[i] = valid ? e * f : 0.f; }
                { const float e = fast_exp2(fminf(p1[i], 60.f)); const float f = fast_rcp(1.f + e);
                  const bool valid = !diag || (kv0 + 32 + kl < qpos); F1[i] = valid ? f : 1.f; p1[i] = valid ? e * f : 0.f; }
            }
            float G[8], Go[8];
#pragma unroll
            for (int g = 0; g < 4; ++g) { G[g] = (F0[4 * g] * F0[4 * g + 1]) * (F0[4 * g + 2] * F0[4 * g + 3]); G[4 + g] = (F1[4 * g] * F1[4 * g + 1]) * (F1[4 * g + 2] * F1[4 * g + 3]); }
#pragma unroll
            for (int g = 0; g < 8; ++g) Go[g] = xhalf_other(G[g]);
            float run = C; float A[8];
#pragma unroll
            for (int g = 7; g >= 0; --g) { A[g] = run * (h == 0 ? Go[g] : 1.f); run *= (G[g] * Go[g]); }
#pragma unroll
            for (int g = 0; g < 4; ++g) {
                { float bt = A[g]; p0[4 * g + 3] *= bt; bt *= F0[4 * g + 3]; p0[4 * g + 2] *= bt; bt *= F0[4 * g + 2]; p0[4 * g + 1] *= bt; bt *= F0[4 * g + 1]; p0[4 * g] *= bt; }
                { float bt = A[4 + g]; p1[4 * g + 3] *= bt; bt *= F1[4 * g + 3]; p1[4 * g + 2] *= bt; bt *= F1[4 * g + 2]; p1[4 * g + 1] *= bt; bt *= F1[4 * g + 1]; p1[4 * g] *= bt; }
            }
            C = run;
            pv_tile(o0, o1, Vs, p0, p1, lane);
            if (__all(C < 1.17549435e-38f)) done = true;
            --t;
        }
        if (t < 0) done = true;
        if (!done && lane == 0) ctl[7] = 1u;
        __syncthreads();
        if (ctl[7] == 0u) break;
        t_top = t_bot - 1;
    }
    write_y(o0, o1, 1.0f, act + rowq * PITCH + C_GA + hh * 64, act + rowq * PITCH + C_QA + hh * 64, h);
}
DI void swa_wg_unit(bf16_t* act, int b, int hk, int Qb, const float* sinks_l, LAS const float* tabS, LAS unsigned char* lds, int wid, int lane) {
    const int r = lane & 31, h = lane >> 5;
    const int Q = Qb * 256, q0 = Q + 32 * wid, qpos = q0 + r;
    const size_t rowq = (size_t)b * SEQ + qpos;
    const int t_hi = (Q >> 6) + 3, t_lo = (Q >= 128) ? ((Q - 128) >> 6) : 0;
    __syncthreads();
    coop_load_tiles(act + (size_t)b * SEQ * PITCH + C_KC + hk * 64, C_VC - C_KC, t_hi, t_hi - t_lo + 1, lds, wid, lane);
    __syncthreads();
    const int tlo = (q0 >= 127) ? ((q0 - 127) >> 6) : 0;
#pragma unroll 1
    for (int g = 0; g < 4; ++g) {
        const int hq = 4 * hk + g;
        LAS const float* tab = tabS + hq * 128;
        bf16x8 qf[4]; load_q(qf, act + rowq * PITCH + C_QC + hq * 64, h);
        f32x16 o0, o1;
#pragma unroll
        for (int i = 0; i < 16; ++i) { o0[i] = 0.f; o1[i] = 0.f; }
        float m = sinks_l[hq] * LOG2E, l = (h == 0) ? 1.0f : 0.f;
        for (int t = tlo; t <= (q0 >> 6); ++t) {
            const int kv0 = t * 64;
            LAS const unsigned char* Ks = lds + (t_hi - t) * 16384; LAS const unsigned char* Vs = Ks + 8192;
            f32x16 p0, p1;
#pragma unroll
            for (int i = 0; i < 16; ++i) { p0[i] = 0.f; p1[i] = 0.f; }
            qk_tile(p0, p1, Ks, qf, r, h);
            const int dq = qpos - kv0 - 4 * h;
            float tmax = NEG_INF;
#pragma unroll
            for (int half = 0; half < 2; ++half) {
                float tb[16];
#pragma unroll
                for (int i = 0; i < 16; ++i) { const int d = dq - 32 * half - ((i & 3) + 8 * (i >> 2)); tb[i] = tab[d < 0 ? 0 : (d > 127 ? 127 : d)]; }
#pragma unroll
                for (int i = 0; i < 16; ++i) asm volatile("" : "+v"(tb[i]));
#pragma unroll
                for (int i = 0; i < 16; ++i) { const int d = dq - 32 * half - ((i & 3) + 8 * (i >> 2)); const bool valid = (unsigned)d < 128u;
                    if (half == 0) { p0[i] = valid ? p0[i] + tb[i] : NEG_INF; tmax = fmaxf(tmax, p0[i]); } else { p1[i] = valid ? p1[i] + tb[i] : NEG_INF; tmax = fmaxf(tmax, p1[i]); } }
            }
            tmax = xhalf_max(tmax);
            const bool grow = (tmax - m) > 16.f;
            if (__ballot(grow) != 0ull) {
                const float mn = grow ? tmax : m, alpha = fast_exp2(m - mn);
                l *= alpha; m = mn;
#pragma unroll
                for (int i = 0; i < 16; ++i) { o0[i] *= alpha; o1[i] *= alpha; }
            }
            float ls = 0.f;
#pragma unroll
            for (int i = 0; i < 16; ++i) { p0[i] = fast_exp2(p0[i] - m); p1[i] = fast_exp2(p1[i] - m); ls += p0[i] + p1[i]; }
            l += ls;
            pv_tile(o0, o1, Vs, p0, p1, lane);
        }
        l = xhalf_sum(l);
        write_y(o0, o1, fast_rcp(l), act + rowq * PITCH + C_GC + hq * 64, act + rowq * PITCH + C_QC + hq * 64, h);
    }
}

DI void moba_kmean_frags(bf16x8 (&khi)[4], bf16x8 (&klo)[4], const float* kpart, int b, int hh, int lane) {
    const int r = lane & 31, h = lane >> 5;
    const float* kp = kpart + ((size_t)(b * 32 + r) * 2) * 512 + hh * 64;
    f32x4 a0[4], a1[4], b0[4], b1[4];
#pragma unroll
    for (int s = 0; s < 4; ++s) { const int d = 16 * s + 8 * h; a0[s] = *(const f32x4*)(kp + d); a1[s] = *(const f32x4*)(kp + d + 4); b0[s] = *(const f32x4*)(kp + 512 + d); b1[s] = *(const f32x4*)(kp + 512 + d + 4); }
#pragma unroll
    for (int s = 0; s < 4; ++s) {
        float km[8];
#pragma unroll
        for (int j = 0; j < 4; ++j) { km[j] = (a0[s][j] + b0[s][j]) * (1.0f / 256.0f); km[4 + j] = (a1[s][j] + b1[s][j]) * (1.0f / 256.0f); }
        u32x4 hi4, lo4;
        hi4.x = cvtpk(km[0], km[1]); hi4.y = cvtpk(km[2], km[3]); hi4.z = cvtpk(km[4], km[5]); hi4.w = cvtpk(km[6], km[7]);
        lo4.x = cvtpk(km[0] - bflo(hi4.x), km[1] - bfhi(hi4.x)); lo4.y = cvtpk(km[2] - bflo(hi4.y), km[3] - bfhi(hi4.y));
        lo4.z = cvtpk(km[4] - bflo(hi4.z), km[5] - bfhi(hi4.z)); lo4.w = cvtpk(km[6] - bflo(hi4.w), km[7] - bfhi(hi4.w));
        khi[s] = __builtin_bit_cast(bf16x8, hi4); klo[s] = __builtin_bit_cast(bf16x8, lo4);
    }
}
DI void moba_sel_core(const bf16x8 (&qf)[4], const bf16x8 (&khi)[4], const bf16x8 (&klo)[4], unsigned* sel, int b, int hh, int q0, int lane) {
    const int r = lane & 31, h = lane >> 5;
    const int qpos = q0 + r, own = q0 >> 8;
    unsigned smask = 0u;
    f32x16 g;
#pragma unroll
    for (int i = 0; i < 16; ++i) g[i] = 0.f;
#pragma unroll
    for (int s = 0; s < 4; ++s) { g = MFMA32(khi[s], qf[s], g); g = MFMA32(klo[s], qf[s], g); }
    float gv[16];
#pragma unroll
    for (int i = 0; i < 16; ++i) { const int j = (i & 3) + 8 * (i >> 2) + 4 * h; gv[i] = (j < own) ? g[i] : NEG_INF; }
#pragma unroll
    for (int it = 0; it < 3; ++it) {
        float bv = NEG_INF; int bj = 64;
#pragma unroll
        for (int i = 0; i < 16; ++i) { const int j = (i & 3) + 8 * (i >> 2) + 4 * h; if (gv[i] > bv) { bv = gv[i]; bj = j; } }
        const float ov = __shfl_xor(bv, 32); const int oj = __shfl_xor(bj, 32);
        const bool mine = (bv > ov) || (bv == ov && bj < oj);
        const float wv = mine ? bv : ov; const int wj = mine ? bj : oj;
        if (wv > NEG_INF) smask |= (1u << wj);
#pragma unroll
        for (int i = 0; i < 16; ++i) { const int j = (i & 3) + 8 * (i >> 2) + 4 * h; if (mine && j == bj) gv[i] = NEG_INF; }
    }
    if (h == 0) sel[(size_t)(b * 8 + hh) * SEQ + qpos] = smask;
}
DI void moba_sel_quad(const bf16_t* act, const bf16x8 (&khi)[4], const bf16x8 (&klo)[4], unsigned* sel, int b, int hh, int q0, int lane) {
    const int r = lane & 31, h = lane >> 5;
    bf16x8 q0f[4], q1f[4], q2f[4], q3f[4];
    const bf16_t* base = act + ((size_t)b * SEQ + q0 + r) * PITCH + C_QB + hh * 64;
    load_q(q0f, base, h); load_q(q1f, base + (size_t)32 * PITCH, h); load_q(q2f, base + (size_t)64 * PITCH, h); load_q(q3f, base + (size_t)96 * PITCH, h);
    moba_sel_core(q0f, khi, klo, sel, b, hh, q0, lane);
    moba_sel_core(q1f, khi, klo, sel, b, hh, q0 + 32, lane);
    moba_sel_core(q2f, khi, klo, sel, b, hh, q0 + 64, lane);
    moba_sel_core(q3f, khi, klo, sel, b, hh, q0 + 96, lane);
}
DI void moba_qk(f32x16& p0, f32x16& p1, float ci, LAS const unsigned char* Kt, const bf16x8 (&qf)[4], int r, int h) {
#pragma unroll
    for (int i = 0; i < 16; ++i) { p0[i] = ci; p1[i] = ci; }
    qk_tile(p0, p1, Kt, qf, r, h);
}
DI void moba_softpv(f32x16& c0, f32x16& c1, f32x16& n0, f32x16& n1, bool has_next, bool first, int qpos, int kv0, float& m, float& l, f32x16& o0, f32x16& o1,
                    float bfar, LAS const float* tab, LAS const unsigned char* Vt, int lane) {
    const int h = lane >> 5;
    if (__ballot((qpos - (kv0 + 63)) < 128) != 0ull) {
        const int dq = qpos - kv0 - 4 * h;
#pragma unroll
        for (int half = 0; half < 2; ++half) {
            float tb[16];
#pragma unroll
            for (int i = 0; i < 16; ++i) { const int d = dq - 32 * half - ((i & 3) + 8 * (i >> 2)); tb[i] = tab[d < 0 ? 0 : (d > 128 ? 128 : d)]; }
#pragma unroll
            for (int i = 0; i < 16; ++i) asm volatile("" : "+v"(tb[i]));
#pragma unroll
            for (int i = 0; i < 16; ++i) { const int d = dq - 32 * half - ((i & 3) + 8 * (i >> 2));
                if (half == 0) c0[i] = (d >= 0) ? c0[i] + (tb[i] - bfar) : NEG_INF; else c1[i] = (d >= 0) ? c1[i] + (tb[i] - bfar) : NEG_INF; }
        }
    }
    float tmax = NEG_INF;
#pragma unroll
    for (int i = 0; i < 16; ++i) tmax = fmaxf(tmax, fmaxf(c0[i], c1[i]));
    tmax = xhalf_max(tmax);
    const bool out_of_band = first ? (fabsf(tmax) > 16.f && tmax > -1e30f) : (tmax > 16.f);
    if (__ballot(out_of_band) != 0ull) {
        const float dl = out_of_band ? tmax : 0.f, alpha = first ? 1.0f : fast_exp2(-dl);
        m += dl; l *= alpha;
#pragma unroll
        for (int i = 0; i < 16; ++i) { c0[i] -= dl; c1[i] -= dl; o0[i] *= alpha; o1[i] *= alpha; }
        if (has_next) {
#pragma unroll
            for (int i = 0; i < 16; ++i) { n0[i] -= dl; n1[i] -= dl; }
        }
    }
    float ls = 0.f;
#pragma unroll
    for (int i = 0; i < 16; ++i) { c0[i] = fast_exp2(c0[i]); c1[i] = fast_exp2(c1[i]); ls += c0[i] + c1[i]; }
    l += ls;
    pv_tile(o0, o1, Vt, c0, c1, lane);
}
DI void moba_group(bf16_t* act, float* ml, int b, int hh, int j, int qpos, int slot, const bf16x8 (&qf)[4], bool live, bool isdiag, int ntiles, LAS const float* tab, LAS const unsigned char* lds, int lane) {
    const int r = lane & 31, h = lane >> 5;
    const size_t rowq = (size_t)b * SEQ + qpos;
    f32x16 o0, o1;
#pragma unroll
    for (int i = 0; i < 16; ++i) { o0[i] = 0.f; o1[i] = 0.f; }
    float m = 0.f, l = 0.f;
    const float bfar = tab[128];
    const int kvb = j * 256;
    LAS const unsigned char* Vb = lds + 32768;
    f32x16 a0, a1, b0, b1;
    moba_qk(a0, a1, bfar, lds, qf, r, h);
    if (ntiles > 1) moba_qk(b0, b1, bfar, lds + 8192, qf, r, h);
    moba_softpv(a0, a1, b0, b1, ntiles > 1, true, qpos, kvb, m, l, o0, o1, bfar, tab, Vb, lane);
    if (ntiles > 1) {
        if (ntiles > 2) moba_qk(a0, a1, bfar - m, lds + 2 * 8192, qf, r, h);
        moba_softpv(b0, b1, a0, a1, ntiles > 2, false, qpos, kvb + 64, m, l, o0, o1, bfar, tab, Vb + 8192, lane);
        if (ntiles > 2) {
            if (ntiles > 3) moba_qk(b0, b1, bfar - m, lds + 3 * 8192, qf, r, h);
            moba_softpv(a0, a1, b0, b1, ntiles > 3, false, qpos, kvb + 128, m, l, o0, o1, bfar, tab, Vb + 2 * 8192, lane);
            if (ntiles > 3) moba_softpv(b0, b1, a0, a1, false, false, qpos, kvb + 192, m, l, o0, o1, bfar, tab, Vb + 3 * 8192, lane);
        }
    }
    l = xhalf_sum(l);
    const float inv = fast_rcp(l);
    u32x4 wq[2][2];
#pragma unroll
    for (int dh = 0; dh < 2; ++dh) {
        const f32x16& o = dh ? o1 : o0;
        u32x2 w[4];
#pragma unroll
        for (int grp = 0; grp < 4; ++grp) { w[grp].x = cvtpk(o[4 * grp] * inv, o[4 * grp + 1] * inv); w[grp].y = cvtpk(o[4 * grp + 2] * inv, o[4 * grp + 3] * inv); }
#pragma unroll
        for (int k = 0; k < 2; ++k) {
            auto rx = __builtin_amdgcn_permlane32_swap(w[2 * k].x, w[2 * k + 1].x, false, false);
            auto ry = __builtin_amdgcn_permlane32_swap(w[2 * k].y, w[2 * k + 1].y, false, false);
            wq[dh][k].x = rx[0]; wq[dh][k].y = ry[0]; wq[dh][k].z = rx[1]; wq[dh][k].w = ry[1];
        }
    }
    if (live) {
        bf16_t* prow = act + rowq * PITCH + (slot < 3 ? (C_KA + (slot * 8 + hh) * 64) : (C_KC + hh * 64));
#pragma unroll
        for (int dh = 0; dh < 2; ++dh)
#pragma unroll
            for (int k = 0; k < 2; ++k) *(u32x4*)(prow + 32 * dh + 8 * (2 * k + h)) = wq[dh][k];

        if (h == 0) { float* mp = ml + ((rowq * 8 + hh) * 4 + slot) * 2; mp[0] = m; mp[1] = l; }
    }
}
struct MobaGrp { int qpos, slot, ntiles; bool live, isdiag; };
DI bool moba_prepare(MobaGrp& G, bf16x8 (&qf)[4], const bf16_t* act, int b, int hh, int j, int total, int g, volatile LAS unsigned short* list, int lane) {
    const int r = lane & 31, h = lane >> 5;
    const int ng = 8 + ((total + 31) >> 5);
    if (g >= ng) return false;
    if (g < 8) { const int slice = 7 - g; G.qpos = j * 256 + slice * 32 + r; G.slot = 3; G.ntiles = (slice >> 1) + 1; G.live = true; G.isdiag = true; }
    else { const int gi = g - 8, idx = gi * 32 + r; G.live = idx < total; const unsigned e = list[G.live ? idx : gi * 32]; G.qpos = (int)(e & 0x1fffu); G.slot = (int)(e >> 13); G.ntiles = 4; G.isdiag = false; }
    load_q(qf, act + ((size_t)b * SEQ + G.qpos) * PITCH + C_QB + hh * 64, h);
    return true;
}
DI void moba_block_phase(bf16_t* act, const unsigned* sel, float* ml, unsigned* qctr, LAS const float* tabM, LAS unsigned char* lds, int tid, int wid, int lane) {
    volatile LAS unsigned* ctl = (volatile LAS unsigned*)(lds + LDS_CTL);
    volatile LAS unsigned short* list = (volatile LAS unsigned short*)(lds + 65536);
    unsigned* gctr = (unsigned*)(LAS unsigned*)(lds + LDS_CTL + 5 * 4);
    if (tid == 0) ctl[6] = __hip_atomic_fetch_add(qctr, 1u, __ATOMIC_RELAXED, __HIP_MEMORY_SCOPE_AGENT);
    for (;;) {
        __syncthreads();
        const unsigned u = ctl[6];
        if (u >= 1024u) break;
        const int j = (int)(u >> 5), bh = (int)(u & 31u), b = bh >> 3, hh = bh & 7;
        const unsigned* selp = sel + (size_t)bh * SEQ;
        const int C = (31 - j) * 32, base = (j + 1) * 256 + wid * C;
        unsigned words[16];
#pragma unroll
        for (int k = 0; k < 16; ++k) { const int idx = k * 64 + lane; const unsigned w = selp[base + (idx < C ? idx : 0)]; words[k] = (idx < C) ? w : 0u; }
        {
            const bf16_t* kb = act + ((size_t)b * SEQ + j * 256 + lane) * PITCH + C_KB + hh * 64 + 8 * wid;
            u32x4 kreg[4], vreg[4];
#pragma unroll
            for (int t = 0; t < 4; ++t) { kreg[t] = *(const u32x4*)(kb + (size_t)t * 64 * PITCH); vreg[t] = *(const u32x4*)(kb + (size_t)t * 64 * PITCH + (C_VB - C_KB)); }
#pragma unroll
            for (int t = 0; t < 4; ++t) { *(LAS u32x4*)(lds + t * 8192 + wid * 1024 + lane * 16) = kreg[t];
                *(LAS u32x4*)(lds + 32768 + t * 8192 + (wid >> 2) * 4096 + lane * 64 + (wid & 3) * 16) = vreg[t]; }
        }
        int cnt = 0;
#pragma unroll
        for (int k = 0; k < 16; ++k) cnt += __popcll(__ballot(((words[k] >> j) & 1u) != 0u));
        if (lane == 0) ctl[8 + wid] = (unsigned)cnt;
        if (tid == 0) ctl[5] = 0u;
        __syncthreads();
        unsigned nxt_unit = 0u;
        if (tid == 0) nxt_unit = __hip_atomic_fetch_add(qctr, 1u, __ATOMIC_RELAXED, __HIP_MEMORY_SCOPE_AGENT);
        int off = 0, total = 0;
#pragma unroll
        for (int w = 0; w < 8; ++w) { const int c = (int)ctl[8 + w]; off += (w < wid) ? c : 0; total += c; }
#pragma unroll
        for (int k = 0; k < 16; ++k) {
            const bool match = ((words[k] >> j) & 1u) != 0u;
            const unsigned long long mask = __ballot(match);
            if (match) list[off + __popcll(mask & ((1ull << lane) - 1ull))] = (unsigned short)((unsigned)(base + k * 64 + lane) | ((unsigned)__popc(words[k] & ((1u << j) - 1u)) << 13));
            off += __popcll(mask);
        }
        __syncthreads();
        LAS const float* tab = tabM + hh * 132;
        MobaGrp Ga; bf16x8 qa[4];
        for (;;) {
            int g = 0; if (lane == 0) g = (int)__hip_atomic_fetch_add(gctr, 1u, __ATOMIC_RELAXED, __HIP_MEMORY_SCOPE_WORKGROUP);
            g = __builtin_amdgcn_readfirstlane(g);
            if (!moba_prepare(Ga, qa, act, b, hh, j, total, g, list, lane)) break;
            moba_group(act, ml, b, hh, j, Ga.qpos, Ga.slot, qa, Ga.live, Ga.isdiag, Ga.ntiles, tab, lds, lane);
        }
        if (tid == 0) ctl[6] = nxt_unit;
    }
}
DI void moba_combine_token(bf16_t* act, const unsigned* sel, const float* ml, int tok, int lane) {
    const int hh = lane >> 3, ch = lane & 7;
    const int b = tok >> 13, qpos = tok & (SEQ - 1);
    bf16_t* rowp = act + (size_t)tok * PITCH;
    const unsigned word = sel[(size_t)(b * 8 + hh) * SEQ + qpos];
    const f32x4* mlp = (const f32x4*)(ml + ((size_t)tok * 8 + hh) * 8);
    const f32x4 a = mlp[0], c = mlp[1];
    const u32x4 v3 = *(const u32x4*)(rowp + C_KC + hh * 64 + ch * 8);
    u32x4 vs[3];
#pragma unroll
    for (int s = 0; s < 3; ++s) vs[s] = *(const u32x4*)(rowp + C_KA + (s * 8 + hh) * 64 + ch * 8);
    const u32x4 g = *(const u32x4*)(rowp + C_GB + hh * 64 + ch * 8);
    const int ns = __popc(word);
    const float m0 = ns > 0 ? a.x : NEG_INF, m1 = ns > 1 ? a.z : NEG_INF, m2 = ns > 2 ? c.x : NEG_INF, m3 = c.z;
    const float M = fmaxf(fmaxf(m0, m1), fmaxf(m2, m3));
    const float w0 = ns > 0 ? a.y * fast_exp2(m0 - M) : 0.f, w1 = ns > 1 ? a.w * fast_exp2(m1 - M) : 0.f, w2 = ns > 2 ? c.y * fast_exp2(m2 - M) : 0.f, w3 = c.w * fast_exp2(m3 - M);
    const float inv = fast_rcp((w0 + w1) + (w2 + w3));
    float acc[8];
    acc[0] = w3 * bflo(v3.x); acc[1] = w3 * bfhi(v3.x); acc[2] = w3 * bflo(v3.y); acc[3] = w3 * bfhi(v3.y); acc[4] = w3 * bflo(v3.z); acc[5] = w3 * bfhi(v3.z); acc[6] = w3 * bflo(v3.w); acc[7] = w3 * bfhi(v3.w);
#pragma unroll
    for (int s = 0; s < 3; ++s) {
        const float w = s == 0 ? w0 : (s == 1 ? w1 : w2);
        const bool use = s < ns;
        u32x4 v = vs[s]; if (!use) v = (u32x4){0u, 0u, 0u, 0u};
        acc[0] += w * bflo(v.x); acc[1] += w * bfhi(v.x); acc[2] += w * bflo(v.y); acc[3] += w * bfhi(v.y); acc[4] += w * bflo(v.z); acc[5] += w * bfhi(v.z); acc[6] += w * bflo(v.w); acc[7] += w * bfhi(v.w);
    }
    u32x4 y;
    y.x = cvtpk(acc[0] * inv * silu_(bflo(g.x)), acc[1] * inv * silu_(bfhi(g.x))); y.y = cvtpk(acc[2] * inv * silu_(bflo(g.y)), acc[3] * inv * silu_(bfhi(g.y)));
    y.z = cvtpk(acc[4] * inv * silu_(bflo(g.z)), acc[5] * inv * silu_(bfhi(g.z))); y.w = cvtpk(acc[6] * inv * silu_(bflo(g.w)), acc[7] * inv * silu_(bfhi(g.w)));
    *(u32x4*)(rowp + C_QB + hh * 64 + ch * 8) = y;
}

__global__ void __launch_bounds__(512, 2) hybrid_fwd(Params p) {
    extern __shared__ __attribute__((aligned(16))) unsigned char lds_raw[];
    cg::grid_group grid = cg::this_grid();
    LAS unsigned char* lds = (LAS unsigned char*)lds_raw;
    const int G = gridDim.x, wg = blockIdx.x;
#define PHASE_VARS \
    int tid = threadIdx.x; asm volatile("" : "+v"(tid)); \
    const int lane = tid & 63, wid = __builtin_amdgcn_readfirstlane(tid >> 6); \
    const int gw = wg * 8 + wid, NGW = G * 8; (void)gw; (void)NGW; (void)lane; \
    size_t zoff_ = 0; asm volatile("" : "+s"(zoff_)); unsigned char* ws = p.ws + zoff_; \
    bf16_t* win = (bf16_t*)(ws + WS_WIN); bf16_t* wp = (bf16_t*)(ws + WS_WP); bf16_t* wo = (bf16_t*)(ws + WS_WO); (void)win; (void)wp; (void)wo; \
    float* ssq = (float*)(ws + WS_SSQ); float* kpart = (float*)(ws + WS_KPART); bf16_t* act = (bf16_t*)(ws + WS_ACT); (void)ssq; (void)kpart; (void)act; \
    LAS float* tabM = (LAS float*)(lds + LDS_TABM); LAS float* tabS = (LAS float*)(lds + LDS_TABS); (void)tabM; (void)tabS;

    if (threadIdx.x < 16) ((LAS unsigned*)(lds + LDS_CTL))[threadIdx.x] = 0u;
    __syncthreads();
    const XcdBarrier xbar = xcd_barrier_post((unsigned*)(p.ws + WS_CTL), (volatile LAS unsigned*)(lds + LDS_CTL));
#define GRID_BAR() xcd_barrier(xbar)
    if (p.sinks[0] > 1.0e30f) grid.sync();
    { PHASE_VARS
    for (int idx = tid; idx < 8 * 129; idx += 512) {
        const int hh = idx / 129, d = idx - hh * 129;
        int bk = d; if (d >= 16) { bk = 16 + (int)(logf((float)d / 16.0f) / 2.0794415416798357f * 16.0f); if (bk > 31) bk = 31; }
        tabM[hh * 132 + d] = p.rel_bias[bk * 16 + hh] * LOG2E;
        if (d < 128) tabS[hh * 128 + d] = p.rel_bias[bk * 16 + 8 + hh] * LOG2E;
    }

    {
        LAS float* scr = (LAS float*)(lds + wid * 16384);
        constexpr int I_IN = (DM / 64) * (DIN / 32), I_P = (512 / 64) * (DM / 32), I_O = (DM / 64) * (DM / 32);
        constexpr int PER_L = I_IN + 3 * I_P + I_O;
        auto decode = [&](int it) {
            TrItem t; const int l = it / PER_L; int rr = it - l * PER_L;
            if (rr < I_IN) { t.W = p.w_in + (size_t)l * DM * DIN; t.N = DIN; t.WT = win + (size_t)l * DIN * DM; t.ldwt = DM; t.ks = p.norm_w + l * DM; t.item = rr; return t; }
            rr -= I_IN;
            if (rr < 3 * I_P) { const int br = rr / I_P; rr -= br * I_P; t.W = (br == 0 ? p.w_pa : br == 1 ? p.w_pb : p.w_pc) + (size_t)l * 512 * DM; t.N = DM;
                t.WT = wp + ((size_t)(l * 3 + br) * 1024) * 1024; t.ldwt = 1024; t.ks = nullptr; t.item = rr; return t; }
            rr -= 3 * I_P;
            t.W = p.w_out + (size_t)l * DM * DM; t.N = DM; t.WT = wo + (size_t)l * DM * DM; t.ldwt = DM; t.ks = nullptr; t.item = rr; return t;
        };
        {
            f32x4 va[8], vb[8]; float sa[8], sb[8];
            int it = gw;
            TrItem ta, tb;
            if (it < PER_L) { ta = decode(it); tr_load(va, sa, ta, lane); }
            while (it < PER_L) {
                const int itn = it + NGW; const bool hn = itn < PER_L;
                if (hn) { tb = decode(itn); tr_load(vb, sb, tb, lane); }
                tr_finish(va, sa, ta, scr, lane);
                if (!hn) break;
                const int itn2 = itn + NGW; const bool hn2 = itn2 < PER_L;
                if (hn2) { ta = decode(itn2); tr_load(va, sa, ta, lane); }
                tr_finish(vb, sb, tb, scr, lane);
                if (!hn2) break;
                it = itn2;
            }
        }
        {
            f32x4 va[4], vb[4];
            int row = gw;
            if (row < T) {
#pragma unroll
                for (int j = 0; j < 4; ++j) va[j] = ((const f32x4*)(p.x + (size_t)row * DM) + lane)[64 * j];
            }
            while (row < T) {
                const int rn_ = row + NGW; const bool hn = rn_ < T;
                if (hn) {
#pragma unroll
                    for (int j = 0; j < 4; ++j) vb[j] = ((const f32x4*)(p.x + (size_t)rn_ * DM) + lane)[64 * j];
                }
                { float s = 0.f;
#pragma unroll
                  for (int j = 0; j < 4; ++j) s += (va[j].x * va[j].x + va[j].y * va[j].y) + (va[j].z * va[j].z + va[j].w * va[j].w);
                  s = wave_sum(s);
                  const float rn = 1.0f / sqrtf(s * (1.0f / DM) + RMS_EPS);
                  u32x2* o8 = (u32x2*)(act + (size_t)row * PITCH + XB_COL) + lane;
#pragma unroll
                  for (int j = 0; j < 4; ++j) { u32x2 w; w.x = cvtpk(va[j].x * rn, va[j].y * rn); w.y = cvtpk(va[j].z * rn, va[j].w * rn); o8[64 * j] = w; }
                  if (lane < 16) ssq[(size_t)row * 16 + lane] = (lane == 0) ? s : 0.f; }
                if (!hn) break;
                const int rn2_ = rn_ + NGW; const bool hn2 = rn2_ < T;
                if (hn2) {
#pragma unroll
                    for (int j = 0; j < 4; ++j) va[j] = ((const f32x4*)(p.x + (size_t)rn2_ * DM) + lane)[64 * j];
                }
                { float s = 0.f;
#pragma unroll
                  for (int j = 0; j < 4; ++j) s += (vb[j].x * vb[j].x + vb[j].y * vb[j].y) + (vb[j].z * vb[j].z + vb[j].w * vb[j].w);
                  s = wave_sum(s);
                  const float rn = 1.0f / sqrtf(s * (1.0f / DM) + RMS_EPS);
                  u32x2* o8 = (u32x2*)(act + (size_t)rn_ * PITCH + XB_COL) + lane;
#pragma unroll
                  for (int j = 0; j < 4; ++j) { u32x2 w; w.x = cvtpk(vb[j].x * rn, vb[j].y * rn); w.y = cvtpk(vb[j].z * rn, vb[j].w * rn); o8[64 * j] = w; }
                  if (lane < 16) ssq[(size_t)rn_ * 16 + lane] = (lane == 0) ? s : 0.f; }
                if (!hn2) break;
                row = rn2_;
            }
        }
    }
    }
    GRID_BAR();

#pragma unroll 1
    for (int layer = 0; layer < DEPTH; ++layer) {
        { PHASE_VARS
          const char* win_l = (const char*)(win + (size_t)layer * DIN * DM);
          SchedIn S; S.O.init(T / 256, NU / 256, G, wg); S.act = (const char*)act; S.win = win_l;
          EpiIn E{act, ssq, kpart, layer != 0};
          pg8::gemm_phase<EpiIn, SchedIn>(lds, PITCH, DM, S, E); }
        if (layer == 0) {
          PHASE_VARS
          int first_idle = (T / 256) * (NU / 256) - 10 * G; if (first_idle < 0 || first_idle >= G) first_idle = 0;
          if (wg >= first_idle) {
              constexpr int I_IN = (DM / 64) * (DIN / 32), I_P = (512 / 64) * (DM / 32), I_O = (DM / 64) * (DM / 32);
              constexpr int PER_L = I_IN + 3 * I_P + I_O;
              weight_tiles_simple(p, win, wp, wo, (LAS float*)(lds + wid * 16384), PER_L + (wg - first_idle) * 8 + wid, 2 * PER_L, (G - first_idle) * 8, lane);
          }
        }
        GRID_BAR();
        {
            PHASE_VARS
            unsigned* sel = (unsigned*)(ws + WS_SEL);
            for (int u4 = gw; u4 < 2048; u4 += NGW) {
                const int hh = (u4 >> 6) & 7, b = u4 >> 9;
                bf16x8 khi[4], klo[4]; moba_kmean_frags(khi, klo, kpart, b, hh, lane);
                moba_sel_quad(act, khi, klo, sel, b, hh, (u4 & 63) * 128, lane);
            }
            volatile LAS unsigned* ctl = (volatile LAS unsigned*)(lds + LDS_CTL);
            for (int u = wg; u < 1024; u += G) {
                const int Qb = u & 31, hh = (u >> 5) & 7, b = u >> 8;
                sb_wg_unit(act, b, hh, Qb, lds, ctl, tid, wid, lane);
            }
            for (int u = wg; u < 256; u += G) {
                const int Qb = u & 31, hk = (u >> 5) & 1, b = u >> 6;
                swa_wg_unit(act, b, hk, Qb, p.sinks + layer * 8, tabS, lds, wid, lane);
            }
        }
        GRID_BAR();
        {
            PHASE_VARS
            moba_block_phase(act, (const unsigned*)(ws + WS_SEL), (float*)(ws + WS_ML), (unsigned*)(ws + WS_CTL) + XCD_BAR_WORDS + layer, tabM, lds, tid, wid, lane);
        }
        GRID_BAR();
        {
            PHASE_VARS
            for (int tok = gw; tok < T; tok += 2 * NGW) {
                moba_combine_token(act, (const unsigned*)(ws + WS_SEL), (const float*)(ws + WS_ML), tok, lane);
                if (tok + NGW < T) moba_combine_token(act, (const unsigned*)(ws + WS_SEL), (const float*)(ws + WS_ML), tok + NGW, lane);
            }
        }
        GRID_BAR();
        { PHASE_VARS
          const char* win_l = (const char*)(win + (size_t)layer * DIN * DM);
          const char* wp_l = (const char*)(wp + (size_t)layer * 3 * 1024 * 1024);
          SchedMerge S; S.O.init(T / 256, DM / 256, G, wg); S.act = (const char*)act; S.win = win_l; S.wp = wp_l;
          EpiMerge E{act, ssq, layer != 0};
          pg8::gemm_phase<EpiMerge, SchedMerge>(lds, PITCH, DM, S, E); }
        GRID_BAR();
        { PHASE_VARS
          const char* wo_l = (const char*)(wo + (size_t)layer * DM * DM);
          SchedOut S; S.O.init(T / 256, DM / 256, G, wg); S.act = (const char*)act; S.wo = wo_l;
          EpiOut E{layer == 0 ? p.x : (const float*)p.out, p.out, act, ssq, layer == DEPTH - 1};
          pg8::gemm_phase<EpiOut, SchedOut>(lds, PITCH, DM, S, E); }
        GRID_BAR();
    }
    PHASE_VARS
    for (int row = gw; row < T; row += 2 * NGW) {
        const int row2 = (row + NGW < T) ? row + NGW : row;
        f32x4* xr = (f32x4*)(p.out + (size_t)row * DM) + lane; f32x4* xr2 = (f32x4*)(p.out + (size_t)row2 * DM) + lane;
        const f32x4* wr_ = (const f32x4*)(p.fnw) + lane;
        f32x4 v[4], v2[4], w[4];
#pragma unroll
        for (int j = 0; j < 4; ++j) { v[j] = xr[64 * j]; v2[j] = xr2[64 * j]; w[j] = wr_[64 * j]; }
        const float rs = row_rstd(ssq, row), rs2 = row_rstd(ssq, row2);
#pragma unroll
        for (int j = 0; j < 4; ++j) { xr[64 * j] = v[j] * rs * w[j]; if (row2 != row) xr2[64 * j] = v2[j] * rs2 * w[j]; }
    }
}

extern "C" void kernel_launch(void* const* d_in, const int* in_sizes, int n_in, void* d_out, int out_size, void* d_ws, size_t ws_size, hipStream_t stream) {
    static int grid = 0;
    if (grid == 0) {
        if (n_in != 10 || in_sizes[0] != T * DM || out_size != T * DM || ws_size < WS_END) { fprintf(stderr, "kernel_launch: unexpected shapes / workspace (%d inputs, ws %zu)\n", n_in, ws_size); grid = -1; return; }
        int dev = 0, cus = 0, per_cu = 0;
        (void)hipGetDevice(&dev);
        (void)hipDeviceGetAttribute(&cus, hipDeviceAttributeMultiprocessorCount, dev);
        if (hipFuncSetAttribute((const void*)hybrid_fwd, hipFuncAttributeMaxDynamicSharedMemorySize, LDS_BYTES) != hipSuccess) { fprintf(stderr, "kernel_launch: hipFuncSetAttribute failed\n"); grid = -1; return; }
        if (hipOccupancyMaxActiveBlocksPerMultiprocessor(&per_cu, (const void*)hybrid_fwd, 512, LDS_BYTES) != hipSuccess || per_cu < 1) { fprintf(stderr, "kernel_launch: occupancy query says %d\n", per_cu); per_cu = 1; }
        (void)hipGetLastError();
        grid = cus * (per_cu > 1 ? 1 : per_cu);
        if (grid <= 0) grid = 256;
    }
    if (grid < 0) return;
    Params p{};
    p.x = (const float*)d_in[0]; p.norm_w = (const float*)d_in[1]; p.w_in = (const float*)d_in[2]; p.w_pa = (const float*)d_in[3]; p.w_pb = (const float*)d_in[4];
    p.w_pc = (const float*)d_in[5]; p.w_out = (const float*)d_in[6]; p.sinks = (const float*)d_in[7]; p.rel_bias = (const float*)d_in[8]; p.fnw = (const float*)d_in[9];
    p.out = (float*)d_out; p.ws = (unsigned char*)d_ws;
    if (hipMemsetAsync((unsigned char*)d_ws + WS_CTL, 0, (size_t)(XCD_BAR_WORDS + 64) * 4, stream) != hipSuccess) { fprintf(stderr, "kernel_launch: hipMemsetAsync of the control words failed\n"); return; }
    void* args[] = {&p};
    hipError_t e = hipLaunchCooperativeKernel((const void*)hybrid_fwd, dim3(grid), dim3(512), args, LDS_BYTES, stream);
    if (e != hipSuccess) fprintf(stderr, "kernel_launch: cooperative launch failed: %s (grid %d)\n", hipGetErrorString(e), grid);
}
```

```cpp
#include <hip/hip_runtime.h>
#include <hip/hip_cooperative_groups.h>
#include <cstdio>
#include <cstdint>
namespace cg = cooperative_groups;

#define LAS __attribute__((address_space(3)))
#define DI __device__ __forceinline__
typedef unsigned short bf16_t;
typedef short bf16x8 __attribute__((ext_vector_type(8)));
typedef short s16x4 __attribute__((ext_vector_type(4)));
typedef float f32x4 __attribute__((ext_vector_type(4)));
typedef float f32x16 __attribute__((ext_vector_type(16)));
typedef unsigned u32x4 __attribute__((ext_vector_type(4)));
typedef unsigned u32x2 __attribute__((ext_vector_type(2)));

constexpr int BATCH = 4, SEQ = 8192, DM = 1024, T = BATCH * SEQ, DEPTH = 2;
constexpr int DIN = 8448, NU = 5376, PITCH = 6400, XB_COL = 5376;
constexpr int C_QA = 0, C_KA = 512, C_VA = 1024, C_GA = 1536, C_QB = 2048, C_KB = 2560, C_VB = 3072, C_GB = 3584, C_QC = 4096, C_KC = 4608, C_VC = 4736, C_GC = 4864;
constexpr int C_MERGED = 512;
constexpr int C_GS = 2560;
constexpr float LOG2E = 1.4426950408889634f;
constexpr float QSCALE = 0.125f * LOG2E;
constexpr float RMS_EPS = 1e-6f;
constexpr float NEG_INF = -__builtin_huge_valf();

constexpr size_t MiB = 1u << 20;
constexpr size_t WS_WIN = 0;
constexpr size_t WS_WP = 33 * MiB;
constexpr size_t WS_WO = 45 * MiB;
constexpr size_t WS_SSQ = 49 * MiB;
constexpr size_t WS_KPART = 51 * MiB;
constexpr size_t WS_ACT = 52 * MiB;
constexpr size_t WS_SEL = 452 * MiB;
constexpr size_t WS_ML = 453 * MiB;
constexpr size_t WS_CTL = 462 * MiB;
constexpr size_t WS_END = 463 * MiB;

constexpr int LDS_MAIN = 131072;
constexpr int LDS_TABM = LDS_MAIN;
constexpr int LDS_TABS = LDS_TABM + 8 * 132 * 4;
constexpr int LDS_CTL = LDS_TABS + 8 * 128 * 4;
constexpr int LDS_BYTES = 143360;

DI unsigned cvtpk(float lo, float hi) { typedef float f2 __attribute__((ext_vector_type(2))); typedef __bf16 b2 __attribute__((ext_vector_type(2))); f2 v = {lo, hi}; b2 b = __builtin_convertvector(v, b2); return __builtin_bit_cast(unsigned, b); }
DI float bf2f(unsigned short b) { return __uint_as_float(((unsigned)b) << 16); }
DI float bflo(unsigned w) { return __uint_as_float(w << 16); }
DI float bfhi(unsigned w) { return __uint_as_float(w & 0xffff0000u); }
DI float wave_sum(float v) {
#pragma unroll
    for (int o = 1; o < 64; o <<= 1) v += __shfl_xor(v, o);
    return v;
}
DI float fast_exp2(float x) { return __builtin_amdgcn_exp2f(x); }
DI float fast_log2(float x) { return __builtin_amdgcn_logf(x); }
DI float fast_rcp(float x) { return __builtin_amdgcn_rcpf(x); }
DI float sigmoidf_(float x) { return fast_rcp(1.f + fast_exp2(-x * LOG2E)); }

#define XB_TMO      128
#define XB_XCNT(j)  (256  + 64 * (j))
#define XB_XSUB(j)  (1280 + 64 * (j))
#define XB_XGEN(j)  (2304 + 64 * (j))
#define XB_TOP      3328
#define XB_TOPGEN   3392
#define XCD_BAR_WORDS 3456
#define XB_SPIN_CAP (1u << 18)
DI unsigned xb_ld(unsigned* p)              { return __hip_atomic_load(p, __ATOMIC_RELAXED, __HIP_MEMORY_SCOPE_AGENT); }
DI unsigned xb_add(unsigned* p, unsigned v) { return __hip_atomic_fetch_add(p, v, __ATOMIC_RELAXED, __HIP_MEMORY_SCOPE_AGENT); }
DI unsigned xb_xcc_id() { return (unsigned)__builtin_amdgcn_s_getreg((3 << 11) | 20) & 0xFu; }
#define XB_SPIN(cond, bar) do { unsigned _sp = 0; while (cond) { __builtin_amdgcn_s_sleep(1); \
    if ((++_sp & 255u) == 0u) { if (xb_ld(&(bar)[XB_TMO])) break; if (_sp > XB_SPIN_CAP) { atomicAdd(&(bar)[XB_TMO], 1u); break; } } } } while (0)
struct XcdBarrier { unsigned* bar; unsigned x; volatile LAS unsigned* st; };
DI XcdBarrier xcd_barrier_post(unsigned* bar, volatile LAS unsigned* st) {
    XcdBarrier b; b.bar = bar; b.x = xb_xcc_id(); b.st = st;
    if (threadIdx.x == 0) (void)xb_add(&bar[XB_XCNT(b.x)], 1u);
    return b;
}
DI void xcd_barrier_complete(unsigned* bar, unsigned x, unsigned& nloc, unsigned& nx) {
    const unsigned G = gridDim.x * gridDim.y * gridDim.z;
    unsigned sum, cnt, mine, sp = 0u;
    for (;;) {
        sum = 0u; cnt = 0u; mine = 0u;
#pragma unroll
        for (unsigned j = 0; j < 16; ++j) { const unsigned c = xb_ld(&bar[XB_XCNT(j)]); sum += c; cnt += (c > 0u) ? 1u : 0u; mine = (j == x) ? c : mine; }
        if (sum == G) break;
        __builtin_amdgcn_s_sleep(1);
        if ((++sp & 255u) == 0u) { if (xb_ld(&bar[XB_TMO])) break; if (sp > XB_SPIN_CAP) { atomicAdd(&bar[XB_TMO], 1u); break; } }
    }
    nloc = mine > 0u ? mine : 1u; nx = cnt > 0u ? cnt : 1u;
}
DI void xcd_barrier(const XcdBarrier& b) {
    asm volatile("s_waitcnt vmcnt(0)" ::: "memory");
    __syncthreads();
    if (threadIdx.x == 0) {
        unsigned* bar = b.bar;
        __builtin_amdgcn_s_waitcnt(0);
        unsigned nloc = b.st[0], nx = b.st[1];
        if (nloc == 0u) { xcd_barrier_complete(bar, b.x, nloc, nx); b.st[0] = nloc; b.st[1] = nx; }
        const unsigned old = xb_add(&bar[XB_XSUB(b.x)], 1u);
        const unsigned gen = old / nloc;
        if (old + 1u == (gen + 1u) * nloc) {
            __builtin_amdgcn_fence(__ATOMIC_RELEASE, "agent");
            asm volatile("s_waitcnt vmcnt(0)" ::: "memory");
            const unsigned og = xb_add(&bar[XB_TOP], 1u);
            const unsigned tg = og / nx;
            if (og + 1u == (tg + 1u) * nx) xb_add(&bar[XB_TOPGEN], 1u);
            else XB_SPIN(xb_ld(&bar[XB_TOPGEN]) == tg, bar);
            __builtin_amdgcn_fence(__ATOMIC_ACQUIRE, "agent");
            xb_add(&bar[XB_XGEN(b.x)], 1u);
            asm volatile("s_waitcnt vmcnt(0)" ::: "memory");
        } else {
            XB_SPIN(xb_ld(&bar[XB_XGEN(b.x)]) == gen, bar);
            __builtin_amdgcn_fence(__ATOMIC_ACQUIRE, "agent");
            asm volatile("s_waitcnt vmcnt(0)" ::: "memory");
        }
    }
    __syncthreads();
}

struct Params {
    const float* x; const float* norm_w; const float* w_in; const float* w_pa; const float* w_pb; const float* w_pc; const float* w_out;
    const float* sinks; const float* rel_bias; const float* fnw; float* out; unsigned char* ws;
};

namespace pg8 {
constexpr int BM = 256, BK = 64, HALF = 128, HTB = HALF * BK * 2, STAGE_BYTES = 8 * HTB, NXCD = 8, WGM = 8;
__host__ __device__ __forceinline__ int lds_byte(int r, int c) { const int st = (r >> 4) * 2 + (c >> 5), rr = r & 15, cc = c & 31, ob = rr * 64 + cc * 2; return st * 1024 + (ob ^ (((ob >> 9) & 1) << 5)); }
__host__ __device__ __forceinline__ void stage_rc(int b, int& R, int& C) { const int st = b / 1024, sb = b % 1024, swz = sb ^ (((sb >> 9) & 1) << 5); R = (st >> 1) * 16 + swz / 64; C = (st & 1) * 32 + (swz % 64) / 2; }
__host__ __device__ __forceinline__ int perm32(int rho) { const int n = rho >> 4, i = rho & 15; return 8 * (i >> 2) + 4 * n + (i & 3); }

struct Tile { int pm, pn; };
struct GUnit { const char* A; const char* B; int nt; int pm, pn, z; };

struct TileOrder {
    int nM, nN, nwg, G, c;
    __device__ void init(int nM_, int nN_, int G_, int c_) { nM = nM_; nN = nN_; nwg = nM * nN; G = G_; c = c_; }
    __device__ bool tile(int i, Tile& u) const {
        const long L = (long)i * G + c; if (L >= nwg) return false;
        int wgid = (int)L; { const int q = nwg / NXCD, r = nwg % NXCD, xcd = wgid % NXCD, off = wgid / NXCD; wgid = (xcd < r ? xcd * (q + 1) : r * (q + 1) + (xcd - r) * q) + off; }
        const int nig = WGM * nN, gid = wgid / nig, fm = gid * WGM, gsz = (nM - fm) < WGM ? (nM - fm) : WGM;
        u.pm = fm + ((wgid % nig) % gsz); u.pn = (wgid % nig) / gsz; return true;
    }
};

template <class Epi, class Sched>
__device__ __forceinline__ void gemm_phase(LAS unsigned char* lds, const int lda, const int ldb, const Sched& S, const Epi& E) {
    int tid = threadIdx.x; asm volatile("" : "+v"(tid));
    const int wid = __builtin_amdgcn_readfirstlane(tid >> 6), lane = tid & 63, wr = wid >> 2, wc = wid & 3, fr = lane & 15, fq = lane >> 4;
    unsigned voffA[2], voffB[2];
#pragma unroll
    for (int i = 0; i < 2; ++i) { int R, C; stage_rc(tid * 16 + i * 8192, R, C); const int Rb = (R & ~31) + perm32(R & 31);
        voffA[i] = (unsigned)(R * lda + C) * 2u; voffB[i] = (unsigned)(Rb * ldb + C) * 2u; }
    const size_t kstep = (size_t)(BK * 2);
    const size_t hstepA = (size_t)HALF * lda * 2, hstepB = (size_t)HALF * ldb * 2;
    const unsigned ldsw = (unsigned)wid * 1024u;
    const int aoff = lds_byte(wr * 64 + fr, fq * 8), boff = lds_byte(wc * 32 + fr, fq * 8);
#define PG8_SA(b, h) (((b) * 2 + (h)) * HTB)
#define PG8_SB(b, h) ((4 + (b) * 2 + (h)) * HTB)
#define PG8_STAGE(bufoff, gbase, voff) do { _Pragma("unroll") for (int _i = 0; _i < 2; ++_i) \
        __builtin_amdgcn_global_load_lds((const unsigned*)((const char*)(gbase) + (voff)[_i]), (LAS unsigned*)(lds + (bufoff) + ldsw + _i * 8192), 16, 0, 0); } while (0)
#define PG8_LDA(dst, b, h) do { _Pragma("unroll") for (int m = 0; m < 4; ++m) _Pragma("unroll") for (int k = 0; k < 2; ++k) dst[m][k] = *(const LAS bf16x8*)(lds + PG8_SA(b, h) + aoff + m * 2048 + k * 1024); } while (0)
#define PG8_LDB(dst, b, h) do { _Pragma("unroll") for (int n = 0; n < 2; ++n) _Pragma("unroll") for (int k = 0; k < 2; ++k) dst[n][k] = *(const LAS bf16x8*)(lds + PG8_SB(b, h) + boff + n * 2048 + k * 1024); } while (0)
#define PG8_MMA(ai, bj, At, Bt) do { __builtin_amdgcn_s_setprio(1); _Pragma("unroll") for (int m = 0; m < 4; ++m) _Pragma("unroll") for (int n = 0; n < 2; ++n) _Pragma("unroll") for (int k = 0; k < 2; ++k) \
        acc[ai][bj][m][n] = __builtin_amdgcn_mfma_f32_16x16x32_bf16(Bt[n][k], At[m][k], acc[ai][bj][m][n], 0, 0, 0); __builtin_amdgcn_s_setprio(0); } while (0)
#define PG8_WAIT_V(n) asm volatile("s_waitcnt vmcnt(" #n ")" ::: "memory")
#define PG8_WAIT_L(n) asm volatile("s_waitcnt lgkmcnt(" #n ")" ::: "memory")
#define PG8_BAR __builtin_amdgcn_s_barrier()
#define PG8_SCHED __builtin_amdgcn_sched_barrier(0)
    GUnit cur, nxt; int ui = 0;
    if (!S.next(0, cur)) return;
    f32x4 acc[2][2][4][2];
#pragma unroll
    for (int a = 0; a < 2; ++a)
#pragma unroll
        for (int b = 0; b < 2; ++b)
#pragma unroll
            for (int m = 0; m < 4; ++m)
#pragma unroll
                for (int n = 0; n < 2; ++n) acc[a][b][m][n] = (f32x4){0.f, 0.f, 0.f, 0.f};
    bf16x8 At[4][2], B0[2][2], B1[2][2];
    const char* cA = cur.A; const char* cB = cur.B;
    PG8_STAGE(PG8_SB(0, 0), cB, voffB); PG8_STAGE(PG8_SB(0, 1), cB + hstepB, voffB); PG8_STAGE(PG8_SA(0, 0), cA, voffA); PG8_STAGE(PG8_SA(0, 1), cA + hstepA, voffA);
    if (wr == 1) PG8_BAR;
    PG8_WAIT_V(2); PG8_BAR;
    PG8_STAGE(PG8_SB(1, 0), cB + kstep, voffB); PG8_STAGE(PG8_SA(1, 0), cA + kstep, voffA); PG8_STAGE(PG8_SB(1, 1), cB + hstepB + kstep, voffB);
    PG8_WAIT_V(6); PG8_BAR;
    for (;;) {
        const bool has_next = S.next(ui + 1, nxt);
        const char* nA = has_next ? nxt.A : cA; const char* nB = has_next ? nxt.B : cB;
        const int nt = cur.nt;
        for (int t = 0; t < nt; t += 2) {
            const bool last = (t == nt - 2);
            const char* a1 = cA + (size_t)(t + 1) * kstep;
            const char* a2 = last ? nA : cA + (size_t)(t + 2) * kstep; const char* b2 = last ? nB : cB + (size_t)(t + 2) * kstep;
            const char* a3 = a2 + kstep; const char* b3 = b2 + kstep;
            PG8_LDB(B0, 0, 0); PG8_LDB(B1, 0, 1); PG8_SCHED; PG8_LDA(At, 0, 0); PG8_STAGE(PG8_SA(1, 1), a1 + hstepA, voffA);
            PG8_WAIT_V(8); PG8_WAIT_L(0); PG8_BAR; PG8_MMA(0, 0, At, B0); PG8_MMA(0, 1, At, B1); PG8_BAR; PG8_SCHED;
            PG8_LDA(At, 0, 1); PG8_STAGE(PG8_SB(0, 0), b2, voffB); PG8_STAGE(PG8_SB(0, 1), b2 + hstepB, voffB); PG8_STAGE(PG8_SA(0, 0), a2, voffA);
            PG8_WAIT_V(8); PG8_WAIT_L(0); PG8_BAR; PG8_MMA(1, 0, At, B0); PG8_MMA(1, 1, At, B1); PG8_BAR; PG8_SCHED;
            PG8_LDB(B0, 1, 0); PG8_LDB(B1, 1, 1); PG8_SCHED; PG8_LDA(At, 1, 0); PG8_STAGE(PG8_SA(0, 1), a2 + hstepA, voffA);
            PG8_WAIT_V(8); PG8_WAIT_L(0); PG8_BAR; PG8_MMA(0, 0, At, B0); PG8_MMA(0, 1, At, B1); PG8_BAR; PG8_SCHED;
            PG8_LDA(At, 1, 1); PG8_STAGE(PG8_SB(1, 0), b3, voffB); PG8_STAGE(PG8_SB(1, 1), b3 + hstepB, voffB); PG8_STAGE(PG8_SA(1, 0), a3, voffA);
            PG8_WAIT_V(8); PG8_WAIT_L(0); PG8_BAR; PG8_MMA(1, 0, At, B0); PG8_MMA(1, 1, At, B1); PG8_BAR; PG8_SCHED;
        }
        if (wr == 0) PG8_BAR;
        E(acc, cur, wr, wc, fr, fq);
        if (!has_next) break;
#pragma unroll
        for (int a = 0; a < 2; ++a)
#pragma unroll
            for (int b = 0; b < 2; ++b)
#pragma unroll
                for (int m = 0; m < 4; ++m)
#pragma unroll
                    for (int n = 0; n < 2; ++n) acc[a][b][m][n] = (f32x4){0.f, 0.f, 0.f, 0.f};
        cur = nxt; cA = nA; cB = nB; ++ui;
        if (wr == 1) PG8_BAR;
    }
    PG8_WAIT_V(0);
    PG8_BAR;
#undef PG8_SA
#undef PG8_SB
#undef PG8_STAGE
#undef PG8_LDA
#undef PG8_LDB
#undef PG8_MMA
#undef PG8_WAIT_V
#undef PG8_WAIT_L
#undef PG8_BAR
#undef PG8_SCHED
}
}

struct SchedIn {
    pg8::TileOrder O; const char* act; const char* win;
    __device__ bool next(int i, pg8::GUnit& u) const { pg8::Tile t; if (!O.tile(i, t)) return false;
        u.pm = t.pm; u.pn = t.pn; u.z = 0; u.nt = 16;
        u.A = act + ((size_t)t.pm * 256 * PITCH + XB_COL) * 2; u.B = win + (size_t)t.pn * 256 * 1024 * 2; return true; }
};
struct SchedMerge {
    pg8::TileOrder O; const char* act; const char* win; const char* wp;
    __device__ bool next(int i, pg8::GUnit& u) const { pg8::Tile t; const int ti = i / 6, z = i - ti * 6; if (!O.tile(ti, t)) return false;
        const int br = z >> 1; u.pm = t.pm; u.pn = t.pn; u.z = z;
        if (z & 1) { u.nt = 8; u.A = act + ((size_t)t.pm * 256 * PITCH + br * 2048) * 2; u.B = wp + ((size_t)(br * 1024 + t.pn * 256) * 1024) * 2; }
        else { u.nt = 16; u.A = act + ((size_t)t.pm * 256 * PITCH + XB_COL) * 2; u.B = win + ((size_t)(NU + br * 1024 + t.pn * 256) * 1024) * 2; }
        return true; }
};
struct SchedOut {
    pg8::TileOrder O; const char* act; const char* wo;
    __device__ bool next(int i, pg8::GUnit& u) const { pg8::Tile t; if (!O.tile(i, t)) return false;
        u.pm = t.pm; u.pn = t.pn; u.z = 0; u.nt = 16;
        u.A = act + ((size_t)t.pm * 256 * PITCH + C_MERGED) * 2; u.B = wo + (size_t)t.pn * 256 * 1024 * 2; return true; }
};

DI float row_rstd(const float* ssq, int row) {
    const f32x4* p = (const f32x4*)(ssq + (size_t)row * 16);
    const f32x4 a = p[0], b = p[1], c = p[2], d = p[3];
    const float s = ((a.x + a.y) + (a.z + a.w)) + ((b.x + b.y) + (b.z + b.w)) + ((c.x + c.y) + (c.z + c.w)) + ((d.x + d.y) + (d.z + d.w));
    return 1.0f / sqrtf(s * (1.0f / DM) + RMS_EPS);
}
DI void rows_rstd8(float (&rs)[2][4], const float* ssq, int row0, int fq) {
    f32x4 part[2][4];
#pragma unroll
    for (int ai = 0; ai < 2; ++ai)
#pragma unroll
        for (int m = 0; m < 4; ++m) part[ai][m] = *(const f32x4*)(ssq + (size_t)(row0 + ai * 128 + m * 16) * 16 + fq * 4);
#pragma unroll
    for (int ai = 0; ai < 2; ++ai)
#pragma unroll
        for (int m = 0; m < 4; ++m) { const f32x4 q = part[ai][m]; float t = (q.x + q.y) + (q.z + q.w); t += __shfl_xor(t, 16); t += __shfl_xor(t, 32);
            rs[ai][m] = 1.0f / sqrtf(t * (1.0f / DM) + RMS_EPS); }
}
struct EpiIn {
    bf16_t* act; const float* ssq; float* kpart; bool use_rs;
    DI void operator()(f32x4 (&acc)[2][2][4][2], const pg8::GUnit& u, int wr, int wc, int fr, int fq) const {
        const int row0 = u.pm * 256 + wr * 64 + fr; const int col0 = u.pn * 256 + wc * 32 + 8 * fq;
        const bool isq = (u.pn < 2) || (u.pn == 8) || (u.pn == 9) || (u.pn == 16) || (u.pn == 17);
        const float sc = isq ? QSCALE : 1.0f;
        const bool iskb = (u.pn == 10) || (u.pn == 11);
        float rs8[2][4];
        if (use_rs) rows_rstd8(rs8, ssq, row0, fq);
        else {
#pragma unroll
            for (int ai = 0; ai < 2; ++ai)
#pragma unroll
                for (int m = 0; m < 4; ++m) rs8[ai][m] = 1.0f;
        }
        f32x4 cs[2][2];
#pragma unroll
        for (int bj = 0; bj < 2; ++bj)
#pragma unroll
            for (int n = 0; n < 2; ++n) cs[bj][n] = (f32x4){0.f, 0.f, 0.f, 0.f};
#pragma unroll
        for (int ai = 0; ai < 2; ++ai)
#pragma unroll
            for (int m = 0; m < 4; ++m) {
                const int row = row0 + ai * 128 + m * 16;
                const float rs = rs8[ai][m] * sc;
                bf16_t* rowp = act + (size_t)row * PITCH + col0;
#pragma unroll
                for (int bj = 0; bj < 2; ++bj) {
                    const f32x4 v0 = acc[ai][bj][m][0] * rs, v1 = acc[ai][bj][m][1] * rs;
                    cs[bj][0] += v0; cs[bj][1] += v1;
                    u32x4 w; w.x = cvtpk(v0[0], v0[1]); w.y = cvtpk(v0[2], v0[3]); w.z = cvtpk(v1[0], v1[1]); w.w = cvtpk(v1[2], v1[3]);
                    *(u32x4*)(rowp + bj * 128) = w;
                }
            }
        if (iskb) {
#pragma unroll
            for (int bj = 0; bj < 2; ++bj)
#pragma unroll
                for (int n = 0; n < 2; ++n)
#pragma unroll
                    for (int j = 0; j < 4; ++j) { float v = cs[bj][n][j]; v += __shfl_xor(v, 1); v += __shfl_xor(v, 2); v += __shfl_xor(v, 4); v += __shfl_xor(v, 8); cs[bj][n][j] = v; }
            if (fr == 0) {
                float* kp = kpart + ((size_t)u.pm * 2 + wr) * 512 + (u.pn - 10) * 256 + wc * 32 + 8 * fq;
#pragma unroll
                for (int bj = 0; bj < 2; ++bj) { *(f32x4*)(kp + bj * 128) = cs[bj][0]; *(f32x4*)(kp + bj * 128 + 4) = cs[bj][1]; }
            }
        }
    }
};
struct EpiMerge {
    bf16_t* act; const float* ssq; bool use_rs;
    DI void operator()(f32x4 (&acc)[2][2][4][2], const pg8::GUnit& u, int wr, int wc, int fr, int fq) const {
        const int row0 = u.pm * 256 + wr * 64 + fr; const int col0 = u.pn * 256 + wc * 32 + 8 * fq;
        const int z = u.z;
        if ((z & 1) == 0) {
            float rs8[2][4];
            if (use_rs) rows_rstd8(rs8, ssq, row0, fq);
            else {
#pragma unroll
                for (int ai = 0; ai < 2; ++ai)
#pragma unroll
                    for (int m = 0; m < 4; ++m) rs8[ai][m] = 1.0f;
            }
#pragma unroll
            for (int ai = 0; ai < 2; ++ai)
#pragma unroll
                for (int m = 0; m < 4; ++m) {
                    bf16_t* gp = act + (size_t)(row0 + ai * 128 + m * 16) * PITCH + C_GS + col0;
                    const float rs = rs8[ai][m];
#pragma unroll
                    for (int bj = 0; bj < 2; ++bj) {
                        const f32x4 v0 = acc[ai][bj][m][0] * rs, v1 = acc[ai][bj][m][1] * rs;
                        u32x4 w; w.x = cvtpk(sigmoidf_(v0[0]), sigmoidf_(v0[1])); w.y = cvtpk(sigmoidf_(v0[2]), sigmoidf_(v0[3]));
                        w.z = cvtpk(sigmoidf_(v1[0]), sigmoidf_(v1[1])); w.w = cvtpk(sigmoidf_(v1[2]), sigmoidf_(v1[3]));
                        *(u32x4*)(gp + bj * 128) = w;
                    }
                }
        } else {
#pragma unroll
            for (int ai = 0; ai < 2; ++ai) {
                u32x4 gq[4][2], mq[4][2];
#pragma unroll
                for (int m = 0; m < 4; ++m) { const bf16_t* rp = act + (size_t)(row0 + ai * 128 + m * 16) * PITCH + col0;
#pragma unroll
                    for (int bj = 0; bj < 2; ++bj) { gq[m][bj] = *(const u32x4*)(rp + C_GS + bj * 128); if (z > 1) mq[m][bj] = *(const u32x4*)(rp + C_MERGED + bj * 128); } }
#pragma unroll
                for (int m = 0; m < 4; ++m) { bf16_t* mp = act + (size_t)(row0 + ai * 128 + m * 16) * PITCH + C_MERGED + col0;
#pragma unroll
                    for (int bj = 0; bj < 2; ++bj) {
                        const u32x4 g = gq[m][bj];
                        const f32x4 a0 = acc[ai][bj][m][0], a1 = acc[ai][bj][m][1];
                        float r0 = bflo(g.x) * a0[0], r1 = bfhi(g.x) * a0[1], r2 = bflo(g.y) * a0[2], r3 = bfhi(g.y) * a0[3];
                        float r4 = bflo(g.z) * a1[0], r5 = bfhi(g.z) * a1[1], r6 = bflo(g.w) * a1[2], r7 = bfhi(g.w) * a1[3];
                        if (z > 1) { const u32x4 pm_ = mq[m][bj];
                            r0 += bflo(pm_.x); r1 += bfhi(pm_.x); r2 += bflo(pm_.y); r3 += bfhi(pm_.y); r4 += bflo(pm_.z); r5 += bfhi(pm_.z); r6 += bflo(pm_.w); r7 += bfhi(pm_.w); }
                        u32x4 w; w.x = cvtpk(r0, r1); w.y = cvtpk(r2, r3); w.z = cvtpk(r4, r5); w.w = cvtpk(r6, r7);
                        *(u32x4*)(mp + bj * 128) = w;
                    } }
            }
        }
    }
};
struct EpiOut {
    const float* resid; float* out; bf16_t* act; float* ssq; bool last;
    DI void operator()(f32x4 (&acc)[2][2][4][2], const pg8::GUnit& u, int wr, int wc, int fr, int fq) const {
        const int row0 = u.pm * 256 + wr * 64 + fr; const int col0 = u.pn * 256 + wc * 32 + 8 * fq;
#pragma unroll
        for (int ai = 0; ai < 2; ++ai)
#pragma unroll
            for (int m = 0; m < 4; ++m) {
                const int row = row0 + ai * 128 + m * 16;
                const size_t off = (size_t)row * DM + col0;
                float q = 0.f;
#pragma unroll
                for (int bj = 0; bj < 2; ++bj) {
                    const f32x4 b0 = *(const f32x4*)(resid + off + bj * 128), b1 = *(const f32x4*)(resid + off + bj * 128 + 4);
                    const f32x4 v0 = b0 + acc[ai][bj][m][0], v1 = b1 + acc[ai][bj][m][1];
                    *(f32x4*)(out + off + bj * 128) = v0; *(f32x4*)(out + off + bj * 128 + 4) = v1;
                    q += (v0[0] * v0[0] + v0[1] * v0[1]) + (v0[2] * v0[2] + v0[3] * v0[3]) + (v1[0] * v1[0] + v1[1] * v1[1]) + (v1[2] * v1[2] + v1[3] * v1[3]);
                    if (!last) { u32x4 w; w.x = cvtpk(v0[0], v0[1]); w.y = cvtpk(v0[2], v0[3]); w.z = cvtpk(v1[0], v1[1]); w.w = cvtpk(v1[2], v1[3]);
                        *(u32x4*)(act + (size_t)row * PITCH + XB_COL + col0 + bj * 128) = w; }
                }
                q += __shfl_xor(q, 16); q += __shfl_xor(q, 32);
                if (fq == 0) ssq[(size_t)row * 16 + u.pn * 4 + wc] = q;
            }
    }
};

struct TrItem { const float* W; bf16_t* WT; const float* ks; int N, ldwt, item; };
DI void tr_load(f32x4 (&v)[8], float (&sc)[8], const TrItem& t, int lane) {
    const int nblk = t.N / 32, kb = t.item / nblk, nb = t.item % nblk, k0 = 64 * kb, n0 = 32 * nb;
#pragma unroll
    for (int i = 0; i < 8; ++i) { const int kk = 8 * i + (lane >> 3), nn = (lane & 7) * 4; v[i] = *(const f32x4*)(t.W + (size_t)(k0 + kk) * t.N + n0 + nn); sc[i] = t.ks ? t.ks[k0 + kk] : 1.0f; }
}
DI void tr_finish(const f32x4 (&v)[8], const float (&sc)[8], const TrItem& t, LAS float* scr, int lane) {
    const int nblk = t.N / 32, kb = t.item / nblk, nb = t.item % nblk, k0 = 64 * kb, n0 = 32 * nb;
#pragma unroll
    for (int i = 0; i < 8; ++i) { const int kk = 8 * i + (lane >> 3), nn = (lane & 7) * 4; const f32x4 w = v[i] * sc[i];
        LAS float* d = scr + kk * 33 + nn; d[0] = w.x; d[1] = w.y; d[2] = w.z; d[3] = w.w; }
    asm volatile("s_waitcnt lgkmcnt(0)" ::: "memory");
    const int c = lane & 7;
#pragma unroll
    for (int j = 0; j < 4; ++j) { const int n = (lane >> 3) + 8 * j; const LAS float* s = scr + (8 * c) * 33 + n;
        u32x4 o; o.x = cvtpk(s[0 * 33], s[1 * 33]); o.y = cvtpk(s[2 * 33], s[3 * 33]); o.z = cvtpk(s[4 * 33], s[5 * 33]); o.w = cvtpk(s[6 * 33], s[7 * 33]);
        *(u32x4*)(t.WT + (size_t)(n0 + n) * t.ldwt + k0 + 8 * c) = o; }
    asm volatile("s_waitcnt lgkmcnt(0)" ::: "memory");
}

DI TrItem tr_decode(const Params& p, bf16_t* win, bf16_t* wp, bf16_t* wo, int it) {
    constexpr int I_IN = (DM / 64) * (DIN / 32), I_P = (512 / 64) * (DM / 32), I_O = (DM / 64) * (DM / 32);
    constexpr int PER_L = I_IN + 3 * I_P + I_O;
    TrItem t; const int l = it / PER_L; int rr = it - l * PER_L;
    if (rr < I_IN) { t.W = p.w_in + (size_t)l * DM * DIN; t.N = DIN; t.WT = win + (size_t)l * DIN * DM; t.ldwt = DM; t.ks = p.norm_w + l * DM; t.item = rr; return t; }
    rr -= I_IN;
    if (rr < 3 * I_P) { const int br = rr / I_P; rr -= br * I_P; t.W = (br == 0 ? p.w_pa : br == 1 ? p.w_pb : p.w_pc) + (size_t)l * 512 * DM; t.N = DM;
        t.WT = wp + ((size_t)(l * 3 + br) * 1024) * 1024; t.ldwt = 1024; t.ks = nullptr; t.item = rr; return t; }
    rr -= 3 * I_P;
    t.W = p.w_out + (size_t)l * DM * DM; t.N = DM; t.WT = wo + (size_t)l * DM * DM; t.ldwt = DM; t.ks = nullptr; t.item = rr; return t;
}
DI void weight_tiles_simple(const Params& p, bf16_t* win, bf16_t* wp, bf16_t* wo, LAS float* scr, int first, int end, int stride, int lane) {
#pragma unroll 1
    for (int it = first; it < end; it += stride) { f32x4 va[8]; float sa[8]; const TrItem ta = tr_decode(p, win, wp, wo, it); tr_load(va, sa, ta, lane); tr_finish(va, sa, ta, scr, lane); }
}

#define MFMA32(a, b, c) __builtin_amdgcn_mfma_f32_32x32x16_bf16((a), (b), (c), 0, 0, 0)
typedef short v4i16_t __attribute__((ext_vector_type(4)));
DI s16x4 vtr(LAS const unsigned char* p) { return __builtin_bit_cast(s16x4, __builtin_amdgcn_ds_read_tr16_b64_v4i16((LAS v4i16_t*)p)); }
DI bf16x8 pack8(const f32x16& x, const int s) {
    u32x4 p; p.x = cvtpk(x[8 * s], x[8 * s + 1]); p.y = cvtpk(x[8 * s + 2], x[8 * s + 3]); p.z = cvtpk(x[8 * s + 4], x[8 * s + 5]); p.w = cvtpk(x[8 * s + 6], x[8 * s + 7]);
    return __builtin_bit_cast(bf16x8, p);
}
DI void qk_tile(f32x16& p0, f32x16& p1, LAS const unsigned char* Ks, const bf16x8 (&qf)[4], int r, int h) {
#pragma unroll
    for (int s = 0; s < 4; ++s) {
        const bf16x8 k0 = *(LAS const bf16x8*)(Ks + (2 * s + h) * 1024 + r * 16);
        const bf16x8 k1 = *(LAS const bf16x8*)(Ks + (2 * s + h) * 1024 + 512 + r * 16);
        p0 = MFMA32(k0, qf[s], p0); p1 = MFMA32(k1, qf[s], p1);
    }
}
DI void pv_tile(f32x16& o0, f32x16& o1, LAS const unsigned char* Vs, const f32x16& p0, const f32x16& p1, int lane) {
    const int h = lane >> 5;
    LAS const unsigned char* vb = Vs + (4 * h + ((lane & 15) >> 2)) * 64 + ((lane >> 4) & 1) * 32 + (lane & 3) * 8;
#pragma unroll
    for (int kh = 0; kh < 2; ++kh)
#pragma unroll
        for (int s2 = 0; s2 < 2; ++s2) {
            const bf16x8 pb = kh ? pack8(p1, s2) : pack8(p0, s2);
            const int ro = (32 * kh + 16 * s2) * 64;
            const s16x4 l0 = vtr(vb + ro), h0 = vtr(vb + ro + 512), l1 = vtr(vb + 4096 + ro), h1 = vtr(vb + 4096 + ro + 512);
            const bf16x8 v0 = (bf16x8){l0[0], l0[1], l0[2], l0[3], h0[0], h0[1], h0[2], h0[3]};
            const bf16x8 v1 = (bf16x8){l1[0], l1[1], l1[2], l1[3], h1[0], h1[1], h1[2], h1[3]};
            o0 = MFMA32(v0, pb, o0); o1 = MFMA32(v1, pb, o1);
        }
}
DI float xhalf_max(float m) { auto rr = __builtin_amdgcn_permlane32_swap(__float_as_uint(m), __float_as_uint(m), false, false); return fmaxf(__uint_as_float(rr[0]), __uint_as_float(rr[1])); }
DI float xhalf_sum(float v) { auto rr = __builtin_amdgcn_permlane32_swap(__float_as_uint(v), __float_as_uint(v), false, false); return __uint_as_float(rr[0]) + __uint_as_float(rr[1]); }
DI float xhalf_other(float v) { const unsigned b = __float_as_uint(v); auto rr = __builtin_amdgcn_permlane32_swap(b, b, false, false); return __uint_as_float(rr[0] ^ rr[1] ^ b); }
DI void store_pair16(bf16_t* base32, u32x2 wa, u32x2 wb, int k, int h) {
    auto rx = __builtin_amdgcn_permlane32_swap(wa.x, wb.x, false, false);
    auto ry = __builtin_amdgcn_permlane32_swap(wa.y, wb.y, false, false);
    u32x4 w; w.x = rx[0]; w.y = ry[0]; w.z = rx[1]; w.w = ry[1];
    *(u32x4*)(base32 + 8 * (2 * k + h)) = w;
}
DI float silu_(float g) { return g * fast_rcp(1.f + fast_exp2(-g * LOG2E)); }
DI void write_y(const f32x16& o0, const f32x16& o1, float scale, const bf16_t* grow, bf16_t* yrow, int h) {
#pragma unroll
    for (int dh = 0; dh < 2; ++dh) {
        u32x2 w[4];
#pragma unroll
        for (int grp = 0; grp < 4; ++grp) {
            const int d0 = 32 * dh + 8 * grp + 4 * h;
            const u32x2 g = *(const u32x2*)(grow + d0);
            const f32x16& o = dh ? o1 : o0;
            const float y0 = o[4 * grp + 0] * scale * silu_(bflo(g.x)), y1 = o[4 * grp + 1] * scale * silu_(bfhi(g.x));
            const float y2 = o[4 * grp + 2] * scale * silu_(bflo(g.y)), y3 = o[4 * grp + 3] * scale * silu_(bfhi(g.y));
            w[grp].x = cvtpk(y0, y1); w[grp].y = cvtpk(y2, y3);
        }
        store_pair16(yrow + 32 * dh, w[0], w[1], 0, h);
        store_pair16(yrow + 32 * dh, w[2], w[3], 1, h);
    }
}
DI void load_q(bf16x8 (&qf)[4], const bf16_t* qrow, int h) {
#pragma unroll
    for (int s = 0; s < 4; ++s) qf[s] = *(const bf16x8*)(qrow + 16 * s + 8 * h);
}

DI void coop_load_tiles(const bf16_t* kbase, int vdelta, int t_hi, int nt, LAS unsigned char* lds, int wid, int lane) {
#pragma unroll 1
    for (int s0 = 0; s0 < nt; s0 += 4) {
        u32x4 kr[4], vr[4];
#pragma unroll
        for (int s = 0; s < 4; ++s) if (s0 + s < nt) { const bf16_t* src = kbase + (size_t)((t_hi - s0 - s) * 64 + lane) * PITCH + 8 * wid; kr[s] = *(const u32x4*)src; vr[s] = *(const u32x4*)(src + vdelta); }
#pragma unroll
        for (int s = 0; s < 4; ++s) if (s0 + s < nt) { *(LAS u32x4*)(lds + (s0 + s) * 16384 + wid * 1024 + lane * 16) = kr[s];
            *(LAS u32x4*)(lds + (s0 + s) * 16384 + 8192 + (wid >> 2) * 4096 + lane * 64 + (wid & 3) * 16) = vr[s]; }
    }
}
DI void sb_wg_unit(bf16_t* act, int b, int hh, int Qb, LAS unsigned char* lds, volatile LAS unsigned* ctl, int tid, int wid, int lane) {
    const int r = lane & 31, h = lane >> 5;
    const int Q = Qb * 256, q0 = Q + 32 * wid, qpos = q0 + r;
    const size_t rowq = (size_t)b * SEQ + qpos;
    bf16x8 qf[4]; load_q(qf, act + rowq * PITCH + C_QA + hh * 64, h);
    f32x16 o0, o1;
#pragma unroll
    for (int i = 0; i < 16; ++i) { o0[i] = 0.f; o1[i] = 0.f; }
    float C = 1.f;
    const bf16_t* kgb = act + (size_t)b * SEQ * PITCH + C_KA + hh * 64;
    int t = q0 >> 6;
    bool done = false;
    int t_top = (Q >> 6) + 3;
#pragma unroll 1
    for (;;) {
        const int t_bot = (t_top - 7) > 0 ? (t_top - 7) : 0, nt = t_top - t_bot + 1;
        __syncthreads();
        if (tid == 0) ctl[7] = 0u;
        coop_load_tiles(kgb, C_VA - C_KA, t_top, nt, lds, wid, lane);
        __syncthreads();
#pragma unroll 1
        while (!done && t >= t_bot) {
            const int kv0 = t * 64;
            LAS const unsigned char* Ks = lds + (t_top - t) * 16384; LAS const unsigned char* Vs = Ks + 8192;
            f32x16 p0, p1;
#pragma unroll
            for (int i = 0; i < 16; ++i) { p0[i] = 0.f; p1[i] = 0.f; }
            qk_tile(p0, p1, Ks, qf, r, h);
            const bool diag = (kv0 + 63 >= q0);
            f32x16 F0, F1;
#pragma unroll
            for (int i = 0; i < 16; ++i) {
                const int kl = (i & 3) + 8 * (i >> 2) + 4 * h;
                { const float e = fast_exp2(fminf(p0[i], 60.f)); const float f = fast_rcp(1.f + e);
                  const bool valid = !diag || (kv0 + kl < qpos); F0[i] = valid ? f : 1.f; p0[i] = valid ? e * f : 0.f; }
                { const float e = fast_exp2(fminf(p1[i], 60.f)); const float f = fast_rcp(1.f + e);
                  const bool valid = !diag || (kv0 + 32 + kl < qpos); F1[i] = valid ? f : 1.f; p1[i] = valid ? e * f : 0.f; }
            }
            float G[8], Go[8];
#pragma unroll
            for (int g = 0; g < 4; ++g) { G[g] = (F0[4 * g] * F0[4 * g + 1]) * (F0[4 * g + 2] * F0[4 * g + 3]); G[4 + g] = (F1[4 * g] * F1[4 * g + 1]) * (F1[4 * g + 2] * F1[4 * g + 3]); }
#pragma unroll
            for (int g = 0; g < 8; ++g) Go[g] = xhalf_other(G[g]);
            float run = C; float A[8];
#pragma unroll
            for (int g = 7; g >= 0; --g) { A[g] = run * (h == 0 ? Go[g] : 1.f); run *= (G[g] * Go[g]); }
#pragma unroll
            for (int g = 0; g < 4; ++g) {
                { float bt = A[g]; p0[4 * g + 3] *= bt; bt *= F0[4 * g + 3]; p0[4 * g + 2] *= bt; bt *= F0[4 * g + 2]; p0[4 * g + 1] *= bt; bt *= F0[4 * g + 1]; p0[4 * g] *= bt; }
                { float bt = A[4 + g]; p1[4 * g + 3] *= bt; bt *= F1[4 * g + 3]; p1[4 * g + 2] *= bt; bt *= F1[4 * g + 2]; p1[4 * g + 1] *= bt; bt *= F1[4 * g + 1]; p1[4 * g] *= bt; }
            }
            C = run;
            pv_tile(o0, o1, Vs, p0, p1, lane);
            if (__all(C < 1.17549435e-38f)) done = true;
            --t;
        }
        if (t < 0) done = true;
        if (!done && lane == 0) ctl[7] = 1u;
        __syncthreads();
        if (ctl[7] == 0u) break;
        t_top = t_bot - 1;
    }
    write_y(o0, o1, 1.0f, act + rowq * PITCH + C_GA + hh * 64, act + rowq * PITCH + C_QA + hh * 64, h);
}
DI void swa_wg_unit(bf16_t* act, int b, int hk, int Qb, const float* sinks_l, LAS const float* tabS, LAS unsigned char* lds, int wid, int lane) {
    const int r = lane & 31, h = lane >> 5;
    const int Q = Qb * 256, q0 = Q + 32 * wid, qpos = q0 + r;
    const size_t rowq = (size_t)b * SEQ + qpos;
    const int t_hi = (Q >> 6) + 3, t_lo = (Q >= 128) ? ((Q - 128) >> 6) : 0;
    __syncthreads();
    coop_load_tiles(act + (size_t)b * SEQ * PITCH + C_KC + hk * 64, C_VC - C_KC, t_hi, t_hi - t_lo + 1, lds, wid, lane);
    __syncthreads();
    const int tlo = (q0 >= 127) ? ((q0 - 127) >> 6) : 0;
#pragma unroll 1
    for (int g = 0; g < 4; ++g) {
        const int hq = 4 * hk + g;
        LAS const float* tab = tabS + hq * 128;
        bf16x8 qf[4]; load_q(qf, act + rowq * PITCH + C_QC + hq * 64, h);
        f32x16 o0, o1;
#pragma unroll
        for (int i = 0; i < 16; ++i) { o0[i] = 0.f; o1[i] = 0.f; }
        float m = sinks_l[hq] * LOG2E, l = (h == 0) ? 1.0f : 0.f;
        for (int t = tlo; t <= (q0 >> 6); ++t) {
            const int kv0 = t * 64;
            LAS const unsigned char* Ks = lds + (t_hi - t) * 16384; LAS const unsigned char* Vs = Ks + 8192;
            f32x16 p0, p1;
#pragma unroll
            for (int i = 0; i < 16; ++i) { p0[i] = 0.f; p1[i] = 0.f; }
            qk_tile(p0, p1, Ks, qf, r, h);
            const int dq = qpos - kv0 - 4 * h;
            float tmax = NEG_INF;
#pragma unroll
            for (int half = 0; half < 2; ++half) {
                float tb[16];
#pragma unroll
                for (int i = 0; i < 16; ++i) { const int d = dq - 32 * half - ((i & 3) + 8 * (i >> 2)); tb[i] = tab[d < 0 ? 0 : (d > 127 ? 127 : d)]; }
#pragma unroll
                for (int i = 0; i < 16; ++i) asm volatile("" : "+v"(tb[i]));
#pragma unroll
                for (int i = 0; i < 16; ++i) { const int d = dq - 32 * half - ((i & 3) + 8 * (i >> 2)); const bool valid = (unsigned)d < 128u;
                    if (half == 0) { p0[i] = valid ? p0[i] + tb[i] : NEG_INF; tmax = fmaxf(tmax, p0[i]); } else { p1[i] = valid ? p1[i] + tb[i] : NEG_INF; tmax = fmaxf(tmax, p1[i]); } }
            }
            tmax = xhalf_max(tmax);
            const bool grow = (tmax - m) > 16.f;
            if (__ballot(grow) != 0ull) {
                const float mn = grow ? tmax : m, alpha = fast_exp2(m - mn);
                l *= alpha; m = mn;
#pragma unroll
                for (int i = 0; i < 16; ++i) { o0[i] *= alpha; o1[i] *= alpha; }
            }
            float ls = 0.f;
#pragma unroll
            for (int i = 0; i < 16; ++i) { p0[i] = fast_exp2(p0[i] - m); p1[i] = fast_exp2(p1[i] - m); ls += p0[i] + p1[i]; }
            l += ls;
            pv_tile(o0, o1, Vs, p0, p1, lane);
        }
        l = xhalf_sum(l);
        write_y(o0, o1, fast_rcp(l), act + rowq * PITCH + C_GC + hq * 64, act + rowq * PITCH + C_QC + hq * 64, h);
    }
}

DI void moba_kmean_frags(bf16x8 (&khi)[4], bf16x8 (&klo)[4], const float* kpart, int b, int hh, int lane) {
    const int r = lane & 31, h = lane >> 5;
    const float* kp = kpart + ((size_t)(b * 32 + r) * 2) * 512 + hh * 64;
    f32x4 a0[4], a1[4], b0[4], b1[4];
#pragma unroll
    for (int s = 0; s < 4; ++s) { const int d = 16 * s + 8 * h; a0[s] = *(const f32x4*)(kp + d); a1[s] = *(const f32x4*)(kp + d + 4); b0[s] = *(const f32x4*)(kp + 512 + d); b1[s] = *(const f32x4*)(kp + 512 + d + 4); }
#pragma unroll
    for (int s = 0; s < 4; ++s) {
        float km[8];
#pragma unroll
        for (int j = 0; j < 4; ++j) { km[j] = (a0[s][j] + b0[s][j]) * (1.0f / 256.0f); km[4 + j] = (a1[s][j] + b1[s][j]) * (1.0f / 256.0f); }
        u32x4 hi4, lo4;
        hi4.x = cvtpk(km[0], km[1]); hi4.y = cvtpk(km[2], km[3]); hi4.z = cvtpk(km[4], km[5]); hi4.w = cvtpk(km[6], km[7]);
        lo4.x = cvtpk(km[0] - bflo(hi4.x), km[1] - bfhi(hi4.x)); lo4.y = cvtpk(km[2] - bflo(hi4.y), km[3] - bfhi(hi4.y));
        lo4.z = cvtpk(km[4] - bflo(hi4.z), km[5] - bfhi(hi4.z)); lo4.w = cvtpk(km[6] - bflo(hi4.w), km[7] - bfhi(hi4.w));
        khi[s] = __builtin_bit_cast(bf16x8, hi4); klo[s] = __builtin_bit_cast(bf16x8, lo4);
    }
}
DI void moba_sel_core(const bf16x8 (&qf)[4], const bf16x8 (&khi)[4], const bf16x8 (&klo)[4], unsigned* sel, int b, int hh, int q0, int lane) {
    const int r = lane & 31, h = lane >> 5;
    const int qpos = q0 + r, own = q0 >> 8;
    unsigned smask = 0u;
    f32x16 g;
#pragma unroll
    for (int i = 0; i < 16; ++i) g[i] = 0.f;
#pragma unroll
    for (int s = 0; s < 4; ++s) { g = MFMA32(khi[s], qf[s], g); g = MFMA32(klo[s], qf[s], g); }
    float gv[16];
#pragma unroll
    for (int i = 0; i < 16; ++i) { const int j = (i & 3) + 8 * (i >> 2) + 4 * h; gv[i] = (j < own) ? g[i] : NEG_INF; }
#pragma unroll
    for (int it = 0; it < 3; ++it) {
        float bv = NEG_INF; int bj = 64;
#pragma unroll
        for (int i = 0; i < 16; ++i) { const int j = (i & 3) + 8 * (i >> 2) + 4 * h; if (gv[i] > bv) { bv = gv[i]; bj = j; } }
        const float ov = __shfl_xor(bv, 32); const int oj = __shfl_xor(bj, 32);
        const bool mine = (bv > ov) || (bv == ov && bj < oj);
        const float wv = mine ? bv : ov; const int wj = mine ? bj : oj;
        if (wv > NEG_INF) smask |= (1u << wj);
#pragma unroll
        for (int i = 0; i < 16; ++i) { const int j = (i & 3) + 8 * (i >> 2) + 4 * h; if (mine && j == bj) gv[i] = NEG_INF; }
    }
    if (h == 0) sel[(size_t)(b * 8 + hh) * SEQ + qpos] = smask;
}
DI void moba_sel_quad(const bf16_t* act, const bf16x8 (&khi)[4], const bf16x8 (&klo)[4], unsigned* sel, int b, int hh, int q0, int lane) {
    const int r = lane & 31, h = lane >> 5;
    bf16x8 q0f[4], q1f[4], q2f[4], q3f[4];
    const bf16_t* base = act + ((size_t)b * SEQ + q0 + r) * PITCH + C_QB + hh * 64;
    load_q(q0f, base, h); load_q(q1f, base + (size_t)32 * PITCH, h); load_q(q2f, base + (size_t)64 * PITCH, h); load_q(q3f, base + (size_t)96 * PITCH, h);
    moba_sel_core(q0f, khi, klo, sel, b, hh, q0, lane);
    moba_sel_core(q1f, khi, klo, sel, b, hh, q0 + 32, lane);
    moba_sel_core(q2f, khi, klo, sel, b, hh, q0 + 64, lane);
    moba_sel_core(q3f, khi, klo, sel, b, hh, q0 + 96, lane);
}
DI void moba_qk(f32x16& p0, f32x16& p1, float ci, LAS const unsigned char* Kt, const bf16x8 (&qf)[4], int r, int h) {
#pragma unroll
    for (int i = 0; i < 16; ++i) { p0[i] = ci; p1[i] = ci; }
    qk_tile(p0, p1, Kt, qf, r, h);
}
DI void moba_softpv(f32x16& c0, f32x16& c1, f32x16& n0, f32x16& n1, bool has_next, bool first, int qpos, int kv0, float& m, float& l, f32x16& o0, f32x16& o1,
                    float bfar, LAS const float* tab, LAS const unsigned char* Vt, int lane) {
    const int h = lane >> 5;
    if (__ballot((qpos - (kv0 + 63)) < 128) != 0ull) {
        const int dq = qpos - kv0 - 4 * h;
#pragma unroll
        for (int half = 0; half < 2; ++half) {
            float tb[16];
#pragma unroll
            for (int i = 0; i < 16; ++i) { const int d = dq - 32 * half - ((i & 3) + 8 * (i >> 2)); tb[i] = tab[d < 0 ? 0 : (d > 128 ? 128 : d)]; }
#pragma unroll
            for (int i = 0; i < 16; ++i) asm volatile("" : "+v"(tb[i]));
#pragma unroll
            for (int i = 0; i < 16; ++i) { const int d = dq - 32 * half - ((i & 3) + 8 * (i >> 2));
                if (half == 0) c0[i] = (d >= 0) ? c0[i] + (tb[i] - bfar) : NEG_INF; else c1[i] = (d >= 0) ? c1[i] + (tb[i] - bfar) : NEG_INF; }
        }
    }
    float tmax = NEG_INF;
#pragma unroll
    for (int i = 0; i < 16; ++i) tmax = fmaxf(tmax, fmaxf(c0[i], c1[i]));
    tmax = xhalf_max(tmax);
    const bool out_of_band = first ? (fabsf(tmax) > 16.f && tmax > -1e30f) : (tmax > 16.f);
    if (__ballot(out_of_band) != 0ull) {
        const float dl = out_of_band ? tmax : 0.f, alpha = first ? 1.0f : fast_exp2(-dl);
        m += dl; l *= alpha;
#pragma unroll
        for (int i = 0; i < 16; ++i) { c0[i] -= dl; c1[i] -= dl; o0[i] *= alpha; o1[i] *= alpha; }
        if (has_next) {
#pragma unroll
            for (int i = 0; i < 16; ++i) { n0[i] -= dl; n1[i] -= dl; }
        }
    }
    float ls = 0.f;
#pragma unroll
    for (int i = 0; i < 16; ++i) { c0[i] = fast_exp2(c0[i]); c1[i] = fast_exp2(c1[i]); ls += c0[i] + c1[i]; }
    l += ls;
    pv_tile(o0, o1, Vt, c0, c1, lane);
}
DI void moba_group(bf16_t* act, float* ml, int b, int hh, int j, int qpos, int slot, const bf16x8 (&qf)[4], bool live, bool isdiag, int ntiles, LAS const float* tab, LAS const unsigned char* lds, int lane) {
    const int r = lane & 31, h = lane >> 5;
    const size_t rowq = (size_t)b * SEQ + qpos;
    f32x16 o0, o1;
#pragma unroll
    for (int i = 0; i < 16; ++i) { o0[i] = 0.f; o1[i] = 0.f; }
    float m = 0.f, l = 0.f;
    const float bfar = tab[128];
    const int kvb = j * 256;
    LAS const unsigned char* Vb = lds + 32768;
    f32x16 a0, a1, b0, b1;
    moba_qk(a0, a1, bfar, lds, qf, r, h);
    if (ntiles > 1) moba_qk(b0, b1, bfar, lds + 8192, qf, r, h);
    moba_softpv(a0, a1, b0, b1, ntiles > 1, true, qpos, kvb, m, l, o0, o1, bfar, tab, Vb, lane);
    if (ntiles > 1) {
        if (ntiles > 2) moba_qk(a0, a1, bfar - m, lds + 2 * 8192, qf, r, h);
        moba_softpv(b0, b1, a0, a1, ntiles > 2, false, qpos, kvb + 64, m, l, o0, o1, bfar, tab, Vb + 8192, lane);
        if (ntiles > 2) {
            if (ntiles > 3) moba_qk(b0, b1, bfar - m, lds + 3 * 8192, qf, r, h);
            moba_softpv(a0, a1, b0, b1, ntiles > 3, false, qpos, kvb + 128, m, l, o0, o1, bfar, tab, Vb + 2 * 8192, lane);
            if (ntiles > 3) moba_softpv(b0, b1, a0, a1, false, false, qpos, kvb + 192, m, l, o0, o1, bfar, tab, Vb + 3 * 8192, lane);
        }
    }
    l = xhalf_sum(l);
    const float inv = fast_rcp(l);
    u32x4 wq[2][2];
#pragma unroll
    for (int dh = 0; dh < 2; ++dh) {
        const f32x16& o = dh ? o1 : o0;
        u32x2 w[4];
#pragma unroll
        for (int grp = 0; grp < 4; ++grp) { w[grp].x = cvtpk(o[4 * grp] * inv, o[4 * grp + 1] * inv); w[grp].y = cvtpk(o[4 * grp + 2] * inv, o[4 * grp + 3] * inv); }
#pragma unroll
        for (int k = 0; k < 2; ++k) {
            auto rx = __builtin_amdgcn_permlane32_swap(w[2 * k].x, w[2 * k + 1].x, false, false);
            auto ry = __builtin_amdgcn_permlane32_swap(w[2 * k].y, w[2 * k + 1].y, false, false);
            wq[dh][k].x = rx[0]; wq[dh][k].y = ry[0]; wq[dh][k].z = rx[1]; wq[dh][k].w = ry[1];
        }
    }
    if (live) {
        bf16_t* prow = act + rowq * PITCH + (slot < 3 ? (C_KA + (slot * 8 + hh) * 64) : (C_KC + hh * 64));
#pragma unroll
        for (int dh = 0; dh < 2; ++dh)
#pragma unroll
            for (int k = 0; k < 2; ++k) *(u32x4*)(prow + 32 * dh + 8 * (2 * k + h)) = wq[dh][k];

        if (h == 0) { float* mp = ml + ((rowq * 8 + hh) * 4 + slot) * 2; mp[0] = m; mp[1] = l; }
    }
}
struct MobaGrp { int qpos, slot, ntiles; bool live, isdiag; };
DI bool moba_prepare(MobaGrp& G, bf16x8 (&qf)[4], const bf16_t* act, int b, int hh, int j, int total, int g, volatile LAS unsigned short* list, int lane) {
    const int r = lane & 31, h = lane >> 5;
    const int ng = 8 + ((total + 31) >> 5);
    if (g >= ng) return false;
    if (g < 8) { const int slice = 7 - g; G.qpos = j * 256 + slice * 32 + r; G.slot = 3; G.ntiles = (slice >> 1) + 1; G.live = true; G.isdiag = true; }
    else { const int gi = g - 8, idx = gi * 32 + r; G.live = idx < total; const unsigned e = list[G.live ? idx : gi * 32]; G.qpos = (int)(e & 0x1fffu); G.slot = (int)(e >> 13); G.ntiles = 4; G.isdiag = false; }
    load_q(qf, act + ((size_t)b * SEQ + G.qpos) * PITCH + C_QB + hh * 64, h);
    return true;
}
DI void moba_block_phase(bf16_t* act, const unsigned* sel, float* ml, unsigned* qctr, LAS const float* tabM, LAS unsigned char* lds, int tid, int wid, int lane) {
    volatile LAS unsigned* ctl = (volatile LAS unsigned*)(lds + LDS_CTL);
    volatile LAS unsigned short* list = (volatile LAS unsigned short*)(lds + 65536);
    unsigned* gctr = (unsigned*)(LAS unsigned*)(lds + LDS_CTL + 5 * 4);
    if (tid == 0) ctl[6] = __hip_atomic_fetch_add(qctr, 1u, __ATOMIC_RELAXED, __HIP_MEMORY_SCOPE_AGENT);
    for (;;) {
        __syncthreads();
        const unsigned u = ctl[6];
        if (u >= 1024u) break;
        const int j = (int)(u >> 5), bh = (int)(u & 31u), b = bh >> 3, hh = bh & 7;
        const unsigned* selp = sel + (size_t)bh * SEQ;
        const int C = (31 - j) * 32, base = (j + 1) * 256 + wid * C;
        unsigned words[16];
#pragma unroll
        for (int k = 0; k < 16; ++k) { const int idx = k * 64 + lane; const unsigned w = selp[base + (idx < C ? idx : 0)]; words[k] = (idx < C) ? w : 0u; }
        {
            const bf16_t* kb = act + ((size_t)b * SEQ + j * 256 + lane) * PITCH + C_KB + hh * 64 + 8 * wid;
            u32x4 kreg[4], vreg[4];
#pragma unroll
            for (int t = 0; t < 4; ++t) { kreg[t] = *(const u32x4*)(kb + (size_t)t * 64 * PITCH); vreg[t] = *(const u32x4*)(kb + (size_t)t * 64 * PITCH + (C_VB - C_KB)); }
#pragma unroll
            for (int t = 0; t < 4; ++t) { *(LAS u32x4*)(lds + t * 8192 + wid * 1024 + lane * 16) = kreg[t];
                *(LAS u32x4*)(lds + 32768 + t * 8192 + (wid >> 2) * 4096 + lane * 64 + (wid & 3) * 16) = vreg[t]; }
        }
        int cnt = 0;
#pragma unroll
        for (int k = 0; k < 16; ++k) cnt += __popcll(__ballot(((words[k] >> j) & 1u) != 0u));
        if (lane == 0) ctl[8 + wid] = (unsigned)cnt;
        if (tid == 0) ctl[5] = 0u;
        __syncthreads();
        unsigned nxt_unit = 0u;
        if (tid == 0) nxt_unit = __hip_atomic_fetch_add(qctr, 1u, __ATOMIC_RELAXED, __HIP_MEMORY_SCOPE_AGENT);
        int off = 0, total = 0;
#pragma unroll
        for (int w = 0; w < 8; ++w) { const int c = (int)ctl[8 + w]; off += (w < wid) ? c : 0; total += c; }
#pragma unroll
        for (int k = 0; k < 16; ++k) {
            const bool match = ((words[k] >> j) & 1u) != 0u;
            const unsigned long long mask = __ballot(match);
            if (match) list[off + __popcll(mask & ((1ull << lane) - 1ull))] = (unsigned short)((unsigned)(base + k * 64 + lane) | ((unsigned)__popc(words[k] & ((1u << j) - 1u)) << 13));
            off += __popcll(mask);
        }
        __syncthreads();
        LAS const float* tab = tabM + hh * 132;
        MobaGrp Ga; bf16x8 qa[4];
        for (;;) {
            int g = 0; if (lane == 0) g = (int)__hip_atomic_fetch_add(gctr, 1u, __ATOMIC_RELAXED, __HIP_MEMORY_SCOPE_WORKGROUP);
            g = __builtin_amdgcn_readfirstlane(g);
            if (!moba_prepare(Ga, qa, act, b, hh, j, total, g, list, lane)) break;
            moba_group(act, ml, b, hh, j, Ga.qpos, Ga.slot, qa, Ga.live, Ga.isdiag, Ga.ntiles, tab, lds, lane);
        }
        if (tid == 0) ctl[6] = nxt_unit;
    }
}
DI void moba_combine_token(bf16_t* act, const unsigned* sel, const float* ml, int tok, int lane) {
    const int hh = lane >> 3, ch = lane & 7;
    const int b = tok >> 13, qpos = tok & (SEQ - 1);
    bf16_t* rowp = act + (size_t)tok * PITCH;
    const unsigned word = sel[(size_t)(b * 8 + hh) * SEQ + qpos];
    const f32x4* mlp = (const f32x4*)(ml + ((size_t)tok * 8 + hh) * 8);
    const f32x4 a = mlp[0], c = mlp[1];
    const u32x4 v3 = *(const u32x4*)(rowp + C_KC + hh * 64 + ch * 8);
    u32x4 vs[3];
#pragma unroll
    for (int s = 0; s < 3; ++s) vs[s] = *(const u32x4*)(rowp + C_KA + (s * 8 + hh) * 64 + ch * 8);
    const u32x4 g = *(const u32x4*)(rowp + C_GB + hh * 64 + ch * 8);
    const int ns = __popc(word);
    const float m0 = ns > 0 ? a.x : NEG_INF, m1 = ns > 1 ? a.z : NEG_INF, m2 = ns > 2 ? c.x : NEG_INF, m3 = c.z;
    const float M = fmaxf(fmaxf(m0, m1), fmaxf(m2, m3));
    const float w0 = ns > 0 ? a.y * fast_exp2(m0 - M) : 0.f, w1 = ns > 1 ? a.w * fast_exp2(m1 - M) : 0.f, w2 = ns > 2 ? c.y * fast_exp2(m2 - M) : 0.f, w3 = c.w * fast_exp2(m3 - M);
    const float inv = fast_rcp((w0 + w1) + (w2 + w3));
    float acc[8];
    acc[0] = w3 * bflo(v3.x); acc[1] = w3 * bfhi(v3.x); acc[2] = w3 * bflo(v3.y); acc[3] = w3 * bfhi(v3.y); acc[4] = w3 * bflo(v3.z); acc[5] = w3 * bfhi(v3.z); acc[6] = w3 * bflo(v3.w); acc[7] = w3 * bfhi(v3.w);
#pragma unroll
    for (int s = 0; s < 3; ++s) {
        const float w = s == 0 ? w0 : (s == 1 ? w1 : w2);
        const bool use = s < ns;
        u32x4 v = vs[s]; if (!use) v = (u32x4){0u, 0u, 0u, 0u};
        acc[0] += w * bflo(v.x); acc[1] += w * bfhi(v.x); acc[2] += w * bflo(v.y); acc[3] += w * bfhi(v.y); acc[4] += w * bflo(v.z); acc[5] += w * bfhi(v.z); acc[6] += w * bflo(v.w); acc[7] += w * bfhi(v.w);
    }
    u32x4 y;
    y.x = cvtpk(acc[0] * inv * silu_(bflo(g.x)), acc[1] * inv * silu_(bfhi(g.x))); y.y = cvtpk(acc[2] * inv * silu_(bflo(g.y)), acc[3] * inv * silu_(bfhi(g.y)));
    y.z = cvtpk(acc[4] * inv * silu_(bflo(g.z)), acc[5] * inv * silu_(bfhi(g.z))); y.w = cvtpk(acc[6] * inv * silu_(bflo(g.w)), acc[7] * inv * silu_(bfhi(g.w)));
    *(u32x4*)(rowp + C_QB + hh * 64 + ch * 8) = y;
}

__global__ void __launch_bounds__(512, 2) hybrid_fwd(Params p) {
    extern __shared__ __attribute__((aligned(16))) unsigned char lds_raw[];
    cg::grid_group grid = cg::this_grid();
    LAS unsigned char* lds = (LAS unsigned char*)lds_raw;
    const int G = gridDim.x, wg = blockIdx.x;
#define PHASE_VARS \
    int tid = threadIdx.x; asm volatile("" : "+v"(tid)); \
    const int lane = tid & 63, wid = __builtin_amdgcn_readfirstlane(tid >> 6); \
    const int gw = wg * 8 + wid, NGW = G * 8; (void)gw; (void)NGW; (void)lane; \
    size_t zoff_ = 0; asm volatile("" : "+s"(zoff_)); unsigned char* ws = p.ws + zoff_; \
    bf16_t* win = (bf16_t*)(ws + WS_WIN); bf16_t* wp = (bf16_t*)(ws + WS_WP); bf16_t* wo = (bf16_t*)(ws + WS_WO); (void)win; (void)wp; (void)wo; \
    float* ssq = (float*)(ws + WS_SSQ); float* kpart = (float*)(ws + WS_KPART); bf16_t* act = (bf16_t*)(ws + WS_ACT); (void)ssq; (void)kpart; (void)act; \
    LAS float* tabM = (LAS float*)(lds + LDS_TABM); LAS float* tabS = (LAS float*)(lds + LDS_TABS); (void)tabM; (void)tabS;

    if (threadIdx.x < 16) ((LAS unsigned*)(lds + LDS_CTL))[threadIdx.x] = 0u;
    __syncthreads();
    const XcdBarrier xbar = xcd_barrier_post((unsigned*)(p.ws + WS_CTL), (volatile LAS unsigned*)(lds + LDS_CTL));
#define GRID_BAR() xcd_barrier(xbar)
    if (p.sinks[0] > 1.0e30f) grid.sync();
    { PHASE_VARS
    for (int idx = tid; idx < 8 * 129; idx += 512) {
        const int hh = idx / 129, d = idx - hh * 129;
        int bk = d; if (d >= 16) { bk = 16 + (int)(logf((float)d / 16.0f) / 2.0794415416798357f * 16.0f); if (bk > 31) bk = 31; }
        tabM[hh * 132 + d] = p.rel_bias[bk * 16 + hh] * LOG2E;
        if (d < 128) tabS[hh * 128 + d] = p.rel_bias[bk * 16 + 8 + hh] * LOG2E;
    }

    {
        LAS float* scr = (LAS float*)(lds + wid * 16384);
        constexpr int I_IN = (DM / 64) * (DIN / 32), I_P = (512 / 64) * (DM / 32), I_O = (DM / 64) * (DM / 32);
        constexpr int PER_L = I_IN + 3 * I_P + I_O;
        auto decode = [&](int it) {
            TrItem t; const int l = it / PER_L; int rr = it - l * PER_L;
            if (rr < I_IN) { t.W = p.w_in + (size_t)l * DM * DIN; t.N = DIN; t.WT = win + (size_t)l * DIN * DM; t.ldwt = DM; t.ks = p.norm_w + l * DM; t.item = rr; return t; }
            rr -= I_IN;
            if (rr < 3 * I_P) { const int br = rr / I_P; rr -= br * I_P; t.W = (br == 0 ? p.w_pa : br == 1 ? p.w_pb : p.w_pc) + (size_t)l * 512 * DM; t.N = DM;
                t.WT = wp + ((size_t)(l * 3 + br) * 1024) * 1024; t.ldwt = 1024; t.ks = nullptr; t.item = rr; return t; }
            rr -= 3 * I_P;
            t.W = p.w_out + (size_t)l * DM * DM; t.N = DM; t.WT = wo + (size_t)l * DM * DM; t.ldwt = DM; t.ks = nullptr; t.item = rr; return t;
        };
        {
            f32x4 va[8], vb[8]; float sa[8], sb[8];
            int it = gw;
            TrItem ta, tb;
            if (it < PER_L) { ta = decode(it); tr_load(va, sa, ta, lane); }
            while (it < PER_L) {
                const int itn = it + NGW; const bool hn = itn < PER_L;
                if (hn) { tb = decode(itn); tr_load(vb, sb, tb, lane); }
                tr_finish(va, sa, ta, scr, lane);
                if (!hn) break;
                const int itn2 = itn + NGW; const bool hn2 = itn2 < PER_L;
                if (hn2) { ta = decode(itn2); tr_load(va, sa, ta, lane); }
                tr_finish(vb, sb, tb, scr, lane);
                if (!hn2) break;
                it = itn2;
            }
        }
        {
            f32x4 va[4], vb[4];
            int row = gw;
            if (row < T) {
#pragma unroll
                for (int j = 0; j < 4; ++j) va[j] = ((const f32x4*)(p.x + (size_t)row * DM) + lane)[64 * j];
            }
            while (row < T) {
                const int rn_ = row + NGW; const bool hn = rn_ < T;
                if (hn) {
#pragma unroll
                    for (int j = 0; j < 4; ++j) vb[j] = ((const f32x4*)(p.x + (size_t)rn_ * DM) + lane)[64 * j];
                }
                { float s = 0.f;
#pragma unroll
                  for (int j = 0; j < 4; ++j) s += (va[j].x * va[j].x + va[j].y * va[j].y) + (va[j].z * va[j].z + va[j].w * va[j].w);
                  s = wave_sum(s);
                  const float rn = 1.0f / sqrtf(s * (1.0f / DM) + RMS_EPS);
                  u32x2* o8 = (u32x2*)(act + (size_t)row * PITCH + XB_COL) + lane;
#pragma unroll
                  for (int j = 0; j < 4; ++j) { u32x2 w; w.x = cvtpk(va[j].x * rn, va[j].y * rn); w.y = cvtpk(va[j].z * rn, va[j].w * rn); o8[64 * j] = w; }
                  if (lane < 16) ssq[(size_t)row * 16 + lane] = (lane == 0) ? s : 0.f; }
                if (!hn) break;
                const int rn2_ = rn_ + NGW; const bool hn2 = rn2_ < T;
                if (hn2) {
#pragma unroll
                    for (int j = 0; j < 4; ++j) va[j] = ((const f32x4*)(p.x + (size_t)rn2_ * DM) + lane)[64 * j];
                }
                { float s = 0.f;
#pragma unroll
                  for (int j = 0; j < 4; ++j) s += (vb[j].x * vb[j].x + vb[j].y * vb[j].y) + (vb[j].z * vb[j].z + vb[j].w * vb[j].w);
                  s = wave_sum(s);
                  const float rn = 1.0f / sqrtf(s * (1.0f / DM) + RMS_EPS);
                  u32x2* o8 = (u32x2*)(act + (size_t)rn_ * PITCH + XB_COL) + lane;
#pragma unroll
                  for (int j = 0; j < 4; ++j) { u32x2 w; w.x = cvtpk(vb[j].x * rn, vb[j].y * rn); w.y = cvtpk(vb[j].z * rn, vb[j].w * rn); o8[64 * j] = w; }
                  if (lane < 16) ssq[(size_t)rn_ * 16 + lane] = (lane == 0) ? s : 0.f; }
                if (!hn2) break;
                row = rn2_;
            }
        }
    }
    }
    GRID_BAR();

#pragma unroll 1
    for (int layer = 0; layer < DEPTH; ++layer) {
        { PHASE_VARS
          const char* win_l = (const char*)(win + (size_t)layer * DIN * DM);
          SchedIn S; S.O.init(T / 256, NU / 256, G, wg); S.act = (const char*)act; S.win = win_l;
          EpiIn E{act, ssq, kpart, layer != 0};
          pg8::gemm_phase<EpiIn, SchedIn>(lds, PITCH, DM, S, E); }
        {
          PHASE_VARS
          int first_idle = (T / 256) * (NU / 256) - 10 * G; if (first_idle < 0 || first_idle >= G) first_idle = 0;
          if (wg >= first_idle) {
              constexpr int I_IN = (DM / 64) * (DIN / 32), I_P = (512 / 64) * (DM / 32), I_O = (DM / 64) * (DM / 32);
              constexpr int PER_L = I_IN + 3 * I_P + I_O;
              const int lo = (layer == 0) ? PER_L : PER_L + I_IN, hi = (layer == 0) ? PER_L + I_IN : 2 * PER_L;
              weight_tiles_simple(p, win, wp, wo, (LAS float*)(lds + wid * 16384), lo + (wg - first_idle) * 8 + wid, hi, (G - first_idle) * 8, lane);
          }
        }
        GRID_BAR();
        {
            PHASE_VARS
            unsigned* sel = (unsigned*)(ws + WS_SEL);
            for (int u4 = gw; u4 < 2048; u4 += NGW) {
                const int hh = (u4 >> 6) & 7, b = u4 >> 9;
                bf16x8 khi[4], klo[4]; moba_kmean_frags(khi, klo, kpart, b, hh, lane);
                moba_sel_quad(act, khi, klo, sel, b, hh, (u4 & 63) * 128, lane);
            }
            volatile LAS unsigned* ctl = (volatile LAS unsigned*)(lds + LDS_CTL);
            for (int u = wg; u < 1024; u += G) {
                const int Qb = u & 31, hh = (u >> 5) & 7, b = u >> 8;
                sb_wg_unit(act, b, hh, Qb, lds, ctl, tid, wid, lane);
            }
            for (int u = wg; u < 256; u += G) {
                const int Qb = u & 31, hk = (u >> 5) & 1, b = u >> 6;
                swa_wg_unit(act, b, hk, Qb, p.sinks + layer * 8, tabS, lds, wid, lane);
            }
        }
        GRID_BAR();
        {
            PHASE_VARS
            moba_block_phase(act, (const unsigned*)(ws + WS_SEL), (float*)(ws + WS_ML), (unsigned*)(ws + WS_CTL) + XCD_BAR_WORDS + layer, tabM, lds, tid, wid, lane);
        }
        GRID_BAR();
        {
            PHASE_VARS
            for (int tok = gw; tok < T; tok += 2 * NGW) {
                moba_combine_token(act, (const unsigned*)(ws + WS_SEL), (const float*)(ws + WS_ML), tok, lane);
                if (tok + NGW < T) moba_combine_token(act, (const unsigned*)(ws + WS_SEL), (const float*)(ws + WS_ML), tok + NGW, lane);
            }
        }
        GRID_BAR();
        { PHASE_VARS
          const char* win_l = (const char*)(win + (size_t)layer * DIN * DM);
          const char* wp_l = (const char*)(wp + (size_t)layer * 3 * 1024 * 1024);
          SchedMerge S; S.O.init(T / 256, DM / 256, G, wg); S.act = (const char*)act; S.win = win_l; S.wp = wp_l;
          EpiMerge E{act, ssq, layer != 0};
          pg8::gemm_phase<EpiMerge, SchedMerge>(lds, PITCH, DM, S, E); }
        GRID_BAR();
        { PHASE_VARS
          const char* wo_l = (const char*)(wo + (size_t)layer * DM * DM);
          SchedOut S; S.O.init(T / 256, DM / 256, G, wg); S.act = (const char*)act; S.wo = wo_l;
          EpiOut E{layer == 0 ? p.x : (const float*)p.out, p.out, act, ssq, layer == DEPTH - 1};
          pg8::gemm_phase<EpiOut, SchedOut>(lds, PITCH, DM, S, E); }
        GRID_BAR();
    }
    PHASE_VARS
    for (int row = gw; row < T; row += 2 * NGW) {
        const int row2 = (row + NGW < T) ? row + NGW : row;
        f32x4* xr = (f32x4*)(p.out + (size_t)row * DM) + lane; f32x4* xr2 = (f32x4*)(p.out + (size_t)row2 * DM) + lane;
        const f32x4* wr_ = (const f32x4*)(p.fnw) + lane;
        f32x4 v[4], v2[4], w[4];
#pragma unroll
        for (int j = 0; j < 4; ++j) { v[j] = xr[64 * j]; v2[j] = xr2[64 * j]; w[j] = wr_[64 * j]; }
        const float rs = row_rstd(ssq, row), rs2 = row_rstd(ssq, row2);
#pragma unroll
        for (int j = 0; j < 4; ++j) { xr[64 * j] = v[j] * rs * w[j]; if (row2 != row) xr2[64 * j] = v2[j] * rs2 * w[j]; }
    }
}

extern "C" void kernel_launch(void* const* d_in, const int* in_sizes, int n_in, void* d_out, int out_size, void* d_ws, size_t ws_size, hipStream_t stream) {
    static int grid = 0;
    if (grid == 0) {
        if (n_in != 10 || in_sizes[0] != T * DM || out_size != T * DM || ws_size < WS_END) { fprintf(stderr, "kernel_launch: unexpected shapes / workspace (%d inputs, ws %zu)\n", n_in, ws_size); grid = -1; return; }
        int dev = 0, cus = 0, per_cu = 0;
        (void)hipGetDevice(&dev);
        (void)hipDeviceGetAttribute(&cus, hipDeviceAttributeMultiprocessorCount, dev);
        if (hipFuncSetAttribute((const void*)hybrid_fwd, hipFuncAttributeMaxDynamicSharedMemorySize, LDS_BYTES) != hipSuccess) { fprintf(stderr, "kernel_launch: hipFuncSetAttribute failed\n"); grid = -1; return; }
        if (hipOccupancyMaxActiveBlocksPerMultiprocessor(&per_cu, (const void*)hybrid_fwd, 512, LDS_BYTES) != hipSuccess || per_cu < 1) { fprintf(stderr, "kernel_launch: occupancy query says %d\n", per_cu); per_cu = 1; }
        (void)hipGetLastError();
        grid = cus * (per_cu > 1 ? 1 : per_cu);
        if (grid <= 0) grid = 256;
    }
    if (grid < 0) return;
    Params p{};
    p.x = (const float*)d_in[0]; p.norm_w = (const float*)d_in[1]; p.w_in = (const float*)d_in[2]; p.w_pa = (const float*)d_in[3]; p.w_pb = (const float*)d_in[4];
    p.w_pc = (const float*)d_in[5]; p.w_out = (const float*)d_in[6]; p.sinks = (const float*)d_in[7]; p.rel_bias = (const float*)d_in[8]; p.fnw = (const float*)d_in[9];
    p.out = (float*)d_out; p.ws = (unsigned char*)d_ws;
    if (hipMemsetAsync((unsigned char*)d_ws + WS_CTL, 0, (size_t)(XCD_BAR_WORDS + 64) * 4, stream) != hipSuccess) { fprintf(stderr, "kernel_launch: hipMemsetAsync of the control words failed\n"); return; }
    void* args[] = {&p};
    hipError_t e = hipLaunchCooperativeKernel((const void*)hybrid_fwd, dim3(grid), dim3(512), args, LDS_BYTES, stream);
    if (e != hipSuccess) fprintf(stderr, "kernel_launch: cooperative launch failed: %s (grid %d)\n", hipGetErrorString(e), grid);
}
```

```cpp
#include <hip/hip_runtime.h>
#include <hip/hip_cooperative_groups.h>
#include <cstdio>
#include <cstdint>
namespace cg = cooperative_groups;

#define LAS __attribute__((address_space(3)))
#define DI __device__ __forceinline__
typedef unsigned short bf16_t;
typedef short bf16x8 __attribute__((ext_vector_type(8)));
typedef short s16x4 __attribute__((ext_vector_type(4)));
typedef float f32x4 __attribute__((ext_vector_type(4)));
typedef float f32x16 __attribute__((ext_vector_type(16)));
typedef unsigned u32x4 __attribute__((ext_vector_type(4)));
typedef unsigned u32x2 __attribute__((ext_vector_type(2)));

constexpr int BATCH = 4, SEQ = 8192, DM = 1024, T = BATCH * SEQ, DEPTH = 2;
constexpr int DIN = 8448, NU = 5376, PITCH = 6400, XB_COL = 5376;
constexpr int C_QA = 0, C_KA = 512, C_VA = 1024, C_GA = 1536, C_QB = 2048, C_KB = 2560, C_VB = 3072, C_GB = 3584, C_QC = 4096, C_KC = 4608, C_VC = 4736, C_GC = 4864;
constexpr int C_MERGED = 512;
constexpr int C_GS = 2560;
constexpr float LOG2E = 1.4426950408889634f;
constexpr float QSCALE = 0.125f * LOG2E;
constexpr float RMS_EPS = 1e-6f;
constexpr float NEG_INF = -__builtin_huge_valf();

constexpr size_t MiB = 1u << 20;
constexpr size_t WS_WIN = 0;
constexpr size_t WS_WP = 33 * MiB;
constexpr size_t WS_WO = 45 * MiB;
constexpr size_t WS_SSQ = 49 * MiB;
constexpr size_t WS_KPART = 51 * MiB;
constexpr size_t WS_ACT = 52 * MiB;
constexpr size_t WS_SEL = 452 * MiB;
constexpr size_t WS_ML = 453 * MiB;
constexpr size_t WS_CTL = 462 * MiB;
constexpr size_t WS_END = 463 * MiB;

constexpr int LDS_MAIN = 131072;
constexpr int LDS_TABM = LDS_MAIN;
constexpr int LDS_TABS = LDS_TABM + 8 * 132 * 4;
constexpr int LDS_CTL = LDS_TABS + 8 * 128 * 4;
constexpr int LDS_RS = LDS_CTL + 64;
constexpr int LDS_BYTES = 155648;

DI unsigned cvtpk(float lo, float hi) { typedef float f2 __attribute__((ext_vector_type(2))); typedef __bf16 b2 __attribute__((ext_vector_type(2))); f2 v = {lo, hi}; b2 b = __builtin_convertvector(v, b2); return __builtin_bit_cast(unsigned, b); }
DI float bf2f(unsigned short b) { return __uint_as_float(((unsigned)b) << 16); }
DI float bflo(unsigned w) { return __uint_as_float(w << 16); }
DI float bfhi(unsigned w) { return __uint_as_float(w & 0xffff0000u); }
DI float wave_sum(float v) {
#pragma unroll
    for (int o = 1; o < 64; o <<= 1) v += __shfl_xor(v, o);
    return v;
}
DI float fast_exp2(float x) { return __builtin_amdgcn_exp2f(x); }
DI float fast_log2(float x) { return __builtin_amdgcn_logf(x); }
DI float fast_rcp(float x) { return __builtin_amdgcn_rcpf(x); }
DI float sigmoidf_(float x) { return fast_rcp(1.f + fast_exp2(-x * LOG2E)); }

#define XB_TMO      128
#define XB_XCNT(j)  (256  + 64 * (j))
#define XB_XSUB(j)  (1280 + 64 * (j))
#define XB_XGEN(j)  (2304 + 64 * (j))
#define XB_TOP      3328
#define XB_TOPGEN   3392
#define XCD_BAR_WORDS 3456
#define XB_SPIN_CAP (1u << 18)
DI unsigned xb_ld(unsigned* p)              { return __hip_atomic_load(p, __ATOMIC_RELAXED, __HIP_MEMORY_SCOPE_AGENT); }
DI unsigned xb_add(unsigned* p, unsigned v) { return __hip_atomic_fetch_add(p, v, __ATOMIC_RELAXED, __HIP_MEMORY_SCOPE_AGENT); }
DI unsigned xb_xcc_id() { return (unsigned)__builtin_amdgcn_s_getreg((3 << 11) | 20) & 0xFu; }
#define XB_SPIN(cond, bar) do { unsigned _sp = 0; while (cond) { __builtin_amdgcn_s_sleep(1); \
    if ((++_sp & 255u) == 0u) { if (xb_ld(&(bar)[XB_TMO])) break; if (_sp > XB_SPIN_CAP) { atomicAdd(&(bar)[XB_TMO], 1u); break; } } } } while (0)
struct XcdBarrier { unsigned* bar; unsigned x; volatile LAS unsigned* st; };
DI XcdBarrier xcd_barrier_post(unsigned* bar, volatile LAS unsigned* st) {
    XcdBarrier b; b.bar = bar; b.x = xb_xcc_id(); b.st = st;
    if (threadIdx.x == 0) (void)xb_add(&bar[XB_XCNT(b.x)], 1u);
    return b;
}
DI void xcd_barrier_complete(unsigned* bar, unsigned x, unsigned& nloc, unsigned& nx) {
    const unsigned G = gridDim.x * gridDim.y * gridDim.z;
    unsigned sum, cnt, mine, sp = 0u;
    for (;;) {
        sum = 0u; cnt = 0u; mine = 0u;
#pragma unroll
        for (unsigned j = 0; j < 16; ++j) { const unsigned c = xb_ld(&bar[XB_XCNT(j)]); sum += c; cnt += (c > 0u) ? 1u : 0u; mine = (j == x) ? c : mine; }
        if (sum == G) break;
        __builtin_amdgcn_s_sleep(1);
        if ((++sp & 255u) == 0u) { if (xb_ld(&bar[XB_TMO])) break; if (sp > XB_SPIN_CAP) { atomicAdd(&bar[XB_TMO], 1u); break; } }
    }
    nloc = mine > 0u ? mine : 1u; nx = cnt > 0u ? cnt : 1u;
}
DI void xcd_barrier(const XcdBarrier& b) {
    asm volatile("s_waitcnt vmcnt(0)" ::: "memory");
    __syncthreads();
    if (threadIdx.x == 0) {
        unsigned* bar = b.bar;
        __builtin_amdgcn_s_waitcnt(0);
        unsigned nloc = b.st[0], nx = b.st[1];
        if (nloc == 0u) { xcd_barrier_complete(bar, b.x, nloc, nx); b.st[0] = nloc; b.st[1] = nx; }
        const unsigned old = xb_add(&bar[XB_XSUB(b.x)], 1u);
        const unsigned gen = old / nloc;
        if (old + 1u == (gen + 1u) * nloc) {
            __builtin_amdgcn_fence(__ATOMIC_RELEASE, "agent");
            asm volatile("s_waitcnt vmcnt(0)" ::: "memory");
            const unsigned og = xb_add(&bar[XB_TOP], 1u);
            const unsigned tg = og / nx;
            if (og + 1u == (tg + 1u) * nx) xb_add(&bar[XB_TOPGEN], 1u);
            else XB_SPIN(xb_ld(&bar[XB_TOPGEN]) == tg, bar);
            __builtin_amdgcn_fence(__ATOMIC_ACQUIRE, "agent");
            xb_add(&bar[XB_XGEN(b.x)], 1u);
            asm volatile("s_waitcnt vmcnt(0)" ::: "memory");
        } else {
            XB_SPIN(xb_ld(&bar[XB_XGEN(b.x)]) == gen, bar);
            __builtin_amdgcn_fence(__ATOMIC_ACQUIRE, "agent");
            asm volatile("s_waitcnt vmcnt(0)" ::: "memory");
        }
    }
    __syncthreads();
}

struct Params {
    const float* x; const float* norm_w; const float* w_in; const float* w_pa; const float* w_pb; const float* w_pc; const float* w_out;
    const float* sinks; const float* rel_bias; const float* fnw; float* out; unsigned char* ws;
};

namespace pg8 {
constexpr int BM = 256, BK = 64, HALF = 128, HTB = HALF * BK * 2, STAGE_BYTES = 8 * HTB, NXCD = 8, WGM = 8;
__host__ __device__ __forceinline__ int lds_byte(int r, int c) { const int st = (r >> 4) * 2 + (c >> 5), rr = r & 15, cc = c & 31, ob = rr * 64 + cc * 2; return st * 1024 + (ob ^ (((ob >> 9) & 1) << 5)); }
__host__ __device__ __forceinline__ void stage_rc(int b, int& R, int& C) { const int st = b / 1024, sb = b % 1024, swz = sb ^ (((sb >> 9) & 1) << 5); R = (st >> 1) * 16 + swz / 64; C = (st & 1) * 32 + (swz % 64) / 2; }
__host__ __device__ __forceinline__ int perm32(int rho) { const int n = rho >> 4, i = rho & 15; return 8 * (i >> 2) + 4 * n + (i & 3); }

struct Tile { int pm, pn; };
struct GUnit { const char* A; const char* B; int nt; int pm, pn, z, idx; };

struct TileOrder {
    int nM, nN, nwg, G, c;
    __device__ void init(int nM_, int nN_, int G_, int c_) { nM = nM_; nN = nN_; nwg = nM * nN; G = G_; c = c_; }
    __device__ bool tile(int i, Tile& u) const {
        const long L = (long)i * G + c; if (L >= nwg) return false;
        int wgid = (int)L; { const int q = nwg / NXCD, r = nwg % NXCD, xcd = wgid % NXCD, off = wgid / NXCD; wgid = (xcd < r ? xcd * (q + 1) : r * (q + 1) + (xcd - r) * q) + off; }
        const int nig = WGM * nN, gid = wgid / nig, fm = gid * WGM, gsz = (nM - fm) < WGM ? (nM - fm) : WGM;
        u.pm = fm + ((wgid % nig) % gsz); u.pn = (wgid % nig) / gsz; return true;
    }
};

template <class Epi, class Sched>
__device__ __forceinline__ void gemm_phase(LAS unsigned char* lds, const int lda, const int ldb, const Sched& S, const Epi& E) {
    int tid = threadIdx.x; asm volatile("" : "+v"(tid));
    const int wid = __builtin_amdgcn_readfirstlane(tid >> 6), lane = tid & 63, wr = wid >> 2, wc = wid & 3, fr = lane & 15, fq = lane >> 4;
    unsigned voffA[2], voffB[2];
#pragma unroll
    for (int i = 0; i < 2; ++i) { int R, C; stage_rc(tid * 16 + i * 8192, R, C); const int Rb = (R & ~31) + perm32(R & 31);
        voffA[i] = (unsigned)(R * lda + C) * 2u; voffB[i] = (unsigned)(Rb * ldb + C) * 2u; }
    const size_t kstep = (size_t)(BK * 2);
    const size_t hstepA = (size_t)HALF * lda * 2, hstepB = (size_t)HALF * ldb * 2;
    const unsigned ldsw = (unsigned)wid * 1024u;
    const int aoff = lds_byte(wr * 64 + fr, fq * 8), boff = lds_byte(wc * 32 + fr, fq * 8);
#define PG8_SA(b, h) (((b) * 2 + (h)) * HTB)
#define PG8_SB(b, h) ((4 + (b) * 2 + (h)) * HTB)
#define PG8_STAGE(bufoff, gbase, voff) do { _Pragma("unroll") for (int _i = 0; _i < 2; ++_i) \
        __builtin_amdgcn_global_load_lds((const unsigned*)((const char*)(gbase) + (voff)[_i]), (LAS unsigned*)(lds + (bufoff) + ldsw + _i * 8192), 16, 0, 0); } while (0)
#define PG8_LDA(dst, b, h) do { _Pragma("unroll") for (int m = 0; m < 4; ++m) _Pragma("unroll") for (int k = 0; k < 2; ++k) dst[m][k] = *(const LAS bf16x8*)(lds + PG8_SA(b, h) + aoff + m * 2048 + k * 1024); } while (0)
#define PG8_LDB(dst, b, h) do { _Pragma("unroll") for (int n = 0; n < 2; ++n) _Pragma("unroll") for (int k = 0; k < 2; ++k) dst[n][k] = *(const LAS bf16x8*)(lds + PG8_SB(b, h) + boff + n * 2048 + k * 1024); } while (0)
#define PG8_MMA(ai, bj, At, Bt) do { __builtin_amdgcn_s_setprio(1); _Pragma("unroll") for (int m = 0; m < 4; ++m) _Pragma("unroll") for (int n = 0; n < 2; ++n) _Pragma("unroll") for (int k = 0; k < 2; ++k) \
        acc[ai][bj][m][n] = __builtin_amdgcn_mfma_f32_16x16x32_bf16(Bt[n][k], At[m][k], acc[ai][bj][m][n], 0, 0, 0); __builtin_amdgcn_s_setprio(0); } while (0)
#define PG8_WAIT_V(n) asm volatile("s_waitcnt vmcnt(" #n ")" ::: "memory")
#define PG8_WAIT_L(n) asm volatile("s_waitcnt lgkmcnt(" #n ")" ::: "memory")
#define PG8_BAR __builtin_amdgcn_s_barrier()
#define PG8_SCHED __builtin_amdgcn_sched_barrier(0)
    GUnit cur, nxt; int ui = 0;
    if (!S.next(0, cur)) return;
    f32x4 acc[2][2][4][2];
#pragma unroll
    for (int a = 0; a < 2; ++a)
#pragma unroll
        for (int b = 0; b < 2; ++b)
#pragma unroll
            for (int m = 0; m < 4; ++m)
#pragma unroll
                for (int n = 0; n < 2; ++n) acc[a][b][m][n] = (f32x4){0.f, 0.f, 0.f, 0.f};
    bf16x8 At[4][2], B0[2][2], B1[2][2];
    const char* cA = cur.A; const char* cB = cur.B;
    PG8_STAGE(PG8_SB(0, 0), cB, voffB); PG8_STAGE(PG8_SB(0, 1), cB + hstepB, voffB); PG8_STAGE(PG8_SA(0, 0), cA, voffA); PG8_STAGE(PG8_SA(0, 1), cA + hstepA, voffA);
    if (wr == 1) PG8_BAR;
    PG8_WAIT_V(2); PG8_BAR;
    PG8_STAGE(PG8_SB(1, 0), cB + kstep, voffB); PG8_STAGE(PG8_SA(1, 0), cA + kstep, voffA); PG8_STAGE(PG8_SB(1, 1), cB + hstepB + kstep, voffB);
    PG8_WAIT_V(6); PG8_BAR;
    for (;;) {
        const bool has_next = S.next(ui + 1, nxt);
        const char* nA = has_next ? nxt.A : cA; const char* nB = has_next ? nxt.B : cB;
        const int nt = cur.nt;
        for (int t = 0; t < nt; t += 2) {
            const bool last = (t == nt - 2);
            const char* a1 = cA + (size_t)(t + 1) * kstep;
            const char* a2 = last ? nA : cA + (size_t)(t + 2) * kstep; const char* b2 = last ? nB : cB + (size_t)(t + 2) * kstep;
            const char* a3 = a2 + kstep; const char* b3 = b2 + kstep;
            PG8_LDB(B0, 0, 0); PG8_LDB(B1, 0, 1); PG8_SCHED; PG8_LDA(At, 0, 0); PG8_STAGE(PG8_SA(1, 1), a1 + hstepA, voffA);
            PG8_WAIT_V(8); PG8_WAIT_L(0); PG8_BAR; PG8_MMA(0, 0, At, B0); PG8_MMA(0, 1, At, B1); PG8_BAR; PG8_SCHED;
            PG8_LDA(At, 0, 1); PG8_STAGE(PG8_SB(0, 0), b2, voffB); PG8_STAGE(PG8_SB(0, 1), b2 + hstepB, voffB); PG8_STAGE(PG8_SA(0, 0), a2, voffA);
            PG8_WAIT_V(8); PG8_WAIT_L(0); PG8_BAR; PG8_MMA(1, 0, At, B0); PG8_MMA(1, 1, At, B1); PG8_BAR; PG8_SCHED;
            PG8_LDB(B0, 1, 0); PG8_LDB(B1, 1, 1); PG8_SCHED; PG8_LDA(At, 1, 0); PG8_STAGE(PG8_SA(0, 1), a2 + hstepA, voffA);
            PG8_WAIT_V(8); PG8_WAIT_L(0); PG8_BAR; PG8_MMA(0, 0, At, B0); PG8_MMA(0, 1, At, B1); PG8_BAR; PG8_SCHED;
            PG8_LDA(At, 1, 1); PG8_STAGE(PG8_SB(1, 0), b3, voffB); PG8_STAGE(PG8_SB(1, 1), b3 + hstepB, voffB); PG8_STAGE(PG8_SA(1, 0), a3, voffA);
            PG8_WAIT_V(8); PG8_WAIT_L(0); PG8_BAR; PG8_MMA(1, 0, At, B0); PG8_MMA(1, 1, At, B1); PG8_BAR; PG8_SCHED;
        }
        if (wr == 0) PG8_BAR;
        E(acc, cur, wr, wc, fr, fq);
        if (!has_next) break;
#pragma unroll
        for (int a = 0; a < 2; ++a)
#pragma unroll
            for (int b = 0; b < 2; ++b)
#pragma unroll
                for (int m = 0; m < 4; ++m)
#pragma unroll
                    for (int n = 0; n < 2; ++n) acc[a][b][m][n] = (f32x4){0.f, 0.f, 0.f, 0.f};
        cur = nxt; cA = nA; cB = nB; ++ui;
        if (wr == 1) PG8_BAR;
    }
    PG8_WAIT_V(0);
    PG8_BAR;
#undef PG8_SA
#undef PG8_SB
#undef PG8_STAGE
#undef PG8_LDA
#undef PG8_LDB
#undef PG8_MMA
#undef PG8_WAIT_V
#undef PG8_WAIT_L
#undef PG8_BAR
#undef PG8_SCHED
}
}

struct SchedIn {
    pg8::TileOrder O; const char* act; const char* win;
    __device__ bool next(int i, pg8::GUnit& u) const { pg8::Tile t; if (!O.tile(i, t)) return false;
        u.pm = t.pm; u.pn = t.pn; u.z = 0; u.nt = 16; u.idx = i;
        u.A = act + ((size_t)t.pm * 256 * PITCH + XB_COL) * 2; u.B = win + (size_t)t.pn * 256 * 1024 * 2; return true; }
};
struct SchedMerge {
    pg8::TileOrder O; const char* act; const char* win; const char* wp;
    __device__ bool next(int i, pg8::GUnit& u) const { pg8::Tile t; const int ti = i / 6, z = i - ti * 6; if (!O.tile(ti, t)) return false;
        const int br = z >> 1; u.pm = t.pm; u.pn = t.pn; u.z = z; u.idx = ti;
        if (z & 1) { u.nt = 8; u.A = act + ((size_t)t.pm * 256 * PITCH + br * 2048) * 2; u.B = wp + ((size_t)(br * 1024 + t.pn * 256) * 1024) * 2; }
        else { u.nt = 16; u.A = act + ((size_t)t.pm * 256 * PITCH + XB_COL) * 2; u.B = win + ((size_t)(NU + br * 1024 + t.pn * 256) * 1024) * 2; }
        return true; }
};
struct SchedOut {
    pg8::TileOrder O; const char* act; const char* wo;
    __device__ bool next(int i, pg8::GUnit& u) const { pg8::Tile t; if (!O.tile(i, t)) return false;
        u.pm = t.pm; u.pn = t.pn; u.z = 0; u.nt = 16; u.idx = i;
        u.A = act + ((size_t)t.pm * 256 * PITCH + C_MERGED) * 2; u.B = wo + (size_t)t.pn * 256 * 1024 * 2; return true; }
};

DI float row_rstd(const float* ssq, int row) {
    const f32x4* p = (const f32x4*)(ssq + (size_t)row * 16);
    const f32x4 a = p[0], b = p[1], c = p[2], d = p[3];
    const float s = ((a.x + a.y) + (a.z + a.w)) + ((b.x + b.y) + (b.z + b.w)) + ((c.x + c.y) + (c.z + c.w)) + ((d.x + d.y) + (d.z + d.w));
    return 1.0f / sqrtf(s * (1.0f / DM) + RMS_EPS);
}
DI void rows_rstd8(float (&rs)[2][4], const float* ssq, int row0, int fq) {
    f32x4 part[2][4];
#pragma unroll
    for (int ai = 0; ai < 2; ++ai)
#pragma unroll
        for (int m = 0; m < 4; ++m) part[ai][m] = *(const f32x4*)(ssq + (size_t)(row0 + ai * 128 + m * 16) * 16 + fq * 4);
#pragma unroll
    for (int ai = 0; ai < 2; ++ai)
#pragma unroll
        for (int m = 0; m < 4; ++m) { const f32x4 q = part[ai][m]; float t = (q.x + q.y) + (q.z + q.w); t += __shfl_xor(t, 16); t += __shfl_xor(t, 32);
            rs[ai][m] = 1.0f / sqrtf(t * (1.0f / DM) + RMS_EPS); }
}
struct EpiIn {
    bf16_t* act; const float* ssq; float* kpart; bool use_rs; LAS const float* rsl;
    DI void operator()(f32x4 (&acc)[2][2][4][2], const pg8::GUnit& u, int wr, int wc, int fr, int fq) const {
        const int row0 = u.pm * 256 + wr * 64 + fr; const int col0 = u.pn * 256 + wc * 32 + 8 * fq;
        const bool isq = (u.pn < 2) || (u.pn == 8) || (u.pn == 9) || (u.pn == 16) || (u.pn == 17);
        const float sc = isq ? QSCALE : 1.0f;
        const bool iskb = (u.pn == 10) || (u.pn == 11);
        float rs8[2][4];
        if (use_rs) {
#pragma unroll
            for (int ai = 0; ai < 2; ++ai)
#pragma unroll
                for (int m = 0; m < 4; ++m) rs8[ai][m] = rsl[u.idx * 256 + wr * 64 + ai * 128 + m * 16 + fr];
        }
        else {
#pragma unroll
            for (int ai = 0; ai < 2; ++ai)
#pragma unroll
                for (int m = 0; m < 4; ++m) rs8[ai][m] = 1.0f;
        }
        f32x4 cs[2][2];
#pragma unroll
        for (int bj = 0; bj < 2; ++bj)
#pragma unroll
            for (int n = 0; n < 2; ++n) cs[bj][n] = (f32x4){0.f, 0.f, 0.f, 0.f};
#pragma unroll
        for (int ai = 0; ai < 2; ++ai)
#pragma unroll
            for (int m = 0; m < 4; ++m) {
                const int row = row0 + ai * 128 + m * 16;
                const float rs = rs8[ai][m] * sc;
                bf16_t* rowp = act + (size_t)row * PITCH + col0;
#pragma unroll
                for (int bj = 0; bj < 2; ++bj) {
                    const f32x4 v0 = acc[ai][bj][m][0] * rs, v1 = acc[ai][bj][m][1] * rs;
                    cs[bj][0] += v0; cs[bj][1] += v1;
                    u32x4 w; w.x = cvtpk(v0[0], v0[1]); w.y = cvtpk(v0[2], v0[3]); w.z = cvtpk(v1[0], v1[1]); w.w = cvtpk(v1[2], v1[3]);
                    *(u32x4*)(rowp + bj * 128) = w;
                }
            }
        if (iskb) {
#pragma unroll
            for (int bj = 0; bj < 2; ++bj)
#pragma unroll
                for (int n = 0; n < 2; ++n)
#pragma unroll
                    for (int j = 0; j < 4; ++j) { float v = cs[bj][n][j]; v += __shfl_xor(v, 1); v += __shfl_xor(v, 2); v += __shfl_xor(v, 4); v += __shfl_xor(v, 8); cs[bj][n][j] = v; }
            if (fr == 0) {
                float* kp = kpart + ((size_t)u.pm * 2 + wr) * 512 + (u.pn - 10) * 256 + wc * 32 + 8 * fq;
#pragma unroll
                for (int bj = 0; bj < 2; ++bj) { *(f32x4*)(kp + bj * 128) = cs[bj][0]; *(f32x4*)(kp + bj * 128 + 4) = cs[bj][1]; }
            }
        }
    }
};
struct EpiMerge {
    bf16_t* act; const float* ssq; bool use_rs; LAS const float* rsl;
    DI void operator()(f32x4 (&acc)[2][2][4][2], const pg8::GUnit& u, int wr, int wc, int fr, int fq) const {
        const int row0 = u.pm * 256 + wr * 64 + fr; const int col0 = u.pn * 256 + wc * 32 + 8 * fq;
        const int z = u.z;
        if ((z & 1) == 0) {
            float rs8[2][4];
            if (use_rs) {
#pragma unroll
                for (int ai = 0; ai < 2; ++ai)
#pragma unroll
                    for (int m = 0; m < 4; ++m) rs8[ai][m] = rsl[u.idx * 256 + wr * 64 + ai * 128 + m * 16 + fr];
            }
            else {
#pragma unroll
                for (int ai = 0; ai < 2; ++ai)
#pragma unroll
                    for (int m = 0; m < 4; ++m) rs8[ai][m] = 1.0f;
            }
#pragma unroll
            for (int ai = 0; ai < 2; ++ai)
#pragma unroll
                for (int m = 0; m < 4; ++m) {
                    bf16_t* gp = act + (size_t)(row0 + ai * 128 + m * 16) * PITCH + C_GS + col0;
                    const float rs = rs8[ai][m];
#pragma unroll
                    for (int bj = 0; bj < 2; ++bj) {
                        const f32x4 v0 = acc[ai][bj][m][0] * rs, v1 = acc[ai][bj][m][1] * rs;
                        u32x4 w; w.x = cvtpk(sigmoidf_(v0[0]), sigmoidf_(v0[1])); w.y = cvtpk(sigmoidf_(v0[2]), sigmoidf_(v0[3]));
                        w.z = cvtpk(sigmoidf_(v1[0]), sigmoidf_(v1[1])); w.w = cvtpk(sigmoidf_(v1[2]), sigmoidf_(v1[3]));
                        *(u32x4*)(gp + bj * 128) = w;
                    }
                }
        } else {
#pragma unroll
            for (int ai = 0; ai < 2; ++ai) {
                u32x4 gq[4][2], mq[4][2];
#pragma unroll
                for (int m = 0; m < 4; ++m) { const bf16_t* rp = act + (size_t)(row0 + ai * 128 + m * 16) * PITCH + col0;
#pragma unroll
                    for (int bj = 0; bj < 2; ++bj) { gq[m][bj] = *(const u32x4*)(rp + C_GS + bj * 128); if (z > 1) mq[m][bj] = *(const u32x4*)(rp + C_MERGED + bj * 128); } }
#pragma unroll
                for (int m = 0; m < 4; ++m) { bf16_t* mp = act + (size_t)(row0 + ai * 128 + m * 16) * PITCH + C_MERGED + col0;
#pragma unroll
                    for (int bj = 0; bj < 2; ++bj) {
                        const u32x4 g = gq[m][bj];
                        const f32x4 a0 = acc[ai][bj][m][0], a1 = acc[ai][bj][m][1];
                        float r0 = bflo(g.x) * a0[0], r1 = bfhi(g.x) * a0[1], r2 = bflo(g.y) * a0[2], r3 = bfhi(g.y) * a0[3];
                        float r4 = bflo(g.z) * a1[0], r5 = bfhi(g.z) * a1[1], r6 = bflo(g.w) * a1[2], r7 = bfhi(g.w) * a1[3];
                        if (z > 1) { const u32x4 pm_ = mq[m][bj];
                            r0 += bflo(pm_.x); r1 += bfhi(pm_.x); r2 += bflo(pm_.y); r3 += bfhi(pm_.y); r4 += bflo(pm_.z); r5 += bfhi(pm_.z); r6 += bflo(pm_.w); r7 += bfhi(pm_.w); }
                        u32x4 w; w.x = cvtpk(r0, r1); w.y = cvtpk(r2, r3); w.z = cvtpk(r4, r5); w.w = cvtpk(r6, r7);
                        *(u32x4*)(mp + bj * 128) = w;
                    } }
            }
        }
    }
};
struct EpiOut {
    const float* resid; float* out; bf16_t* act; float* ssq; bool last;
    DI void operator()(f32x4 (&acc)[2][2][4][2], const pg8::GUnit& u, int wr, int wc, int fr, int fq) const {
        const int row0 = u.pm * 256 + wr * 64 + fr; const int col0 = u.pn * 256 + wc * 32 + 8 * fq;
#pragma unroll
        for (int ai = 0; ai < 2; ++ai)
#pragma unroll
            for (int m = 0; m < 4; ++m) {
                const int row = row0 + ai * 128 + m * 16;
                const size_t off = (size_t)row * DM + col0;
                float q = 0.f;
#pragma unroll
                for (int bj = 0; bj < 2; ++bj) {
                    const f32x4 b0 = *(const f32x4*)(resid + off + bj * 128), b1 = *(const f32x4*)(resid + off + bj * 128 + 4);
                    const f32x4 v0 = b0 + acc[ai][bj][m][0], v1 = b1 + acc[ai][bj][m][1];
                    *(f32x4*)(out + off + bj * 128) = v0; *(f32x4*)(out + off + bj * 128 + 4) = v1;
                    q += (v0[0] * v0[0] + v0[1] * v0[1]) + (v0[2] * v0[2] + v0[3] * v0[3]) + (v1[0] * v1[0] + v1[1] * v1[1]) + (v1[2] * v1[2] + v1[3] * v1[3]);
                    if (!last) { u32x4 w; w.x = cvtpk(v0[0], v0[1]); w.y = cvtpk(v0[2], v0[3]); w.z = cvtpk(v1[0], v1[1]); w.w = cvtpk(v1[2], v1[3]);
                        *(u32x4*)(act + (size_t)row * PITCH + XB_COL + col0 + bj * 128) = w; }
                }
                q += __shfl_xor(q, 16); q += __shfl_xor(q, 32);
                if (fq == 0) ssq[(size_t)row * 16 + u.pn * 4 + wc] = q;
            }
    }
};

struct TrItem { const float* W; bf16_t* WT; const float* ks; int N, ldwt, item; };
DI void tr_load(f32x4 (&v)[8], float (&sc)[8], const TrItem& t, int lane) {
    const int nblk = t.N / 32, kb = t.item / nblk, nb = t.item % nblk, k0 = 64 * kb, n0 = 32 * nb;
#pragma unroll
    for (int i = 0; i < 8; ++i) { const int kk = 8 * i + (lane >> 3), nn = (lane & 7) * 4; v[i] = *(const f32x4*)(t.W + (size_t)(k0 + kk) * t.N + n0 + nn); sc[i] = t.ks ? t.ks[k0 + kk] : 1.0f; }
}
DI void tr_finish(const f32x4 (&v)[8], const float (&sc)[8], const TrItem& t, LAS float* scr, int lane) {
    const int nblk = t.N / 32, kb = t.item / nblk, nb = t.item % nblk, k0 = 64 * kb, n0 = 32 * nb;
#pragma unroll
    for (int i = 0; i < 8; ++i) { const int kk = 8 * i + (lane >> 3), nn = (lane & 7) * 4; const f32x4 w = v[i] * sc[i];
        LAS float* d = scr + kk * 33 + nn; d[0] = w.x; d[1] = w.y; d[2] = w.z; d[3] = w.w; }
    asm volatile("s_waitcnt lgkmcnt(0)" ::: "memory");
    const int c = lane & 7;
#pragma unroll
    for (int j = 0; j < 4; ++j) { const int n = (lane >> 3) + 8 * j; const LAS float* s = scr + (8 * c) * 33 + n;
        u32x4 o; o.x = cvtpk(s[0 * 33], s[1 * 33]); o.y = cvtpk(s[2 * 33], s[3 * 33]); o.z = cvtpk(s[4 * 33], s[5 * 33]); o.w = cvtpk(s[6 * 33], s[7 * 33]);
        *(u32x4*)(t.WT + (size_t)(n0 + n) * t.ldwt + k0 + 8 * c) = o; }
    asm volatile("s_waitcnt lgkmcnt(0)" ::: "memory");
}

DI TrItem tr_decode(const Params& p, bf16_t* win, bf16_t* wp, bf16_t* wo, int it) {
    constexpr int I_IN = (DM / 64) * (DIN / 32), I_P = (512 / 64) * (DM / 32), I_O = (DM / 64) * (DM / 32);
    constexpr int PER_L = I_IN + 3 * I_P + I_O;
    TrItem t; const int l = it / PER_L; int rr = it - l * PER_L;
    if (rr < I_IN) { t.W = p.w_in + (size_t)l * DM * DIN; t.N = DIN; t.WT = win + (size_t)l * DIN * DM; t.ldwt = DM; t.ks = p.norm_w + l * DM; t.item = rr; return t; }
    rr -= I_IN;
    if (rr < 3 * I_P) { const int br = rr / I_P; rr -= br * I_P; t.W = (br == 0 ? p.w_pa : br == 1 ? p.w_pb : p.w_pc) + (size_t)l * 512 * DM; t.N = DM;
        t.WT = wp + ((size_t)(l * 3 + br) * 1024) * 1024; t.ldwt = 1024; t.ks = nullptr; t.item = rr; return t; }
    rr -= 3 * I_P;
    t.W = p.w_out + (size_t)l * DM * DM; t.N = DM; t.WT = wo + (size_t)l * DM * DM; t.ldwt = DM; t.ks = nullptr; t.item = rr; return t;
}
DI void weight_tiles_simple(const Params& p, bf16_t* win, bf16_t* wp, bf16_t* wo, LAS float* scr, int first, int end, int stride, int lane) {
#pragma unroll 1
    for (int it = first; it < end; it += stride) { f32x4 va[8]; float sa[8]; const TrItem ta = tr_decode(p, win, wp, wo, it); tr_load(va, sa, ta, lane); tr_finish(va, sa, ta, scr, lane); }
}

#define MFMA32(a, b, c) __builtin_amdgcn_mfma_f32_32x32x16_bf16((a), (b), (c), 0, 0, 0)
typedef short v4i16_t __attribute__((ext_vector_type(4)));
DI s16x4 vtr(LAS const unsigned char* p) { return __builtin_bit_cast(s16x4, __builtin_amdgcn_ds_read_tr16_b64_v4i16((LAS v4i16_t*)p)); }
DI bf16x8 pack8(const f32x16& x, const int s) {
    u32x4 p; p.x = cvtpk(x[8 * s], x[8 * s + 1]); p.y = cvtpk(x[8 * s + 2], x[8 * s + 3]); p.z = cvtpk(x[8 * s + 4], x[8 * s + 5]); p.w = cvtpk(x[8 * s + 6], x[8 * s + 7]);
    return __builtin_bit_cast(bf16x8, p);
}
DI void qk_tile(f32x16& p0, f32x16& p1, LAS const unsigned char* Ks, const bf16x8 (&qf)[4], int r, int h) {
#pragma unroll
    for (int s = 0; s < 4; ++s) {
        const bf16x8 k0 = *(LAS const bf16x8*)(Ks + (2 * s + h) * 1024 + r * 16);
        const bf16x8 k1 = *(LAS const bf16x8*)(Ks + (2 * s + h) * 1024 + 512 + r * 16);
        p0 = MFMA32(k0, qf[s], p0); p1 = MFMA32(k1, qf[s], p1);
    }
}
DI void pv_tile(f32x16& o0, f32x16& o1, LAS const unsigned char* Vs, const f32x16& p0, const f32x16& p1, int lane) {
    const int h = lane >> 5;
    LAS const unsigned char* vb = Vs + (4 * h + ((lane & 15) >> 2)) * 64 + ((lane >> 4) & 1) * 32 + (lane & 3) * 8;
#pragma unroll
    for (int kh = 0; kh < 2; ++kh)
#pragma unroll
        for (int s2 = 0; s2 < 2; ++s2) {
            const bf16x8 pb = kh ? pack8(p1, s2) : pack8(p0, s2);
            const int ro = (32 * kh + 16 * s2) * 64;
            const s16x4 l0 = vtr(vb + ro), h0 = vtr(vb + ro + 512), l1 = vtr(vb + 4096 + ro), h1 = vtr(vb + 4096 + ro + 512);
            const bf16x8 v0 = (bf16x8){l0[0], l0[1], l0[2], l0[3], h0[0], h0[1], h0[2], h0[3]};
            const bf16x8 v1 = (bf16x8){l1[0], l1[1], l1[2], l1[3], h1[0], h1[1], h1[2], h1[3]};
            o0 = MFMA32(v0, pb, o0); o1 = MFMA32(v1, pb, o1);
        }
}
DI float xhalf_max(float m) { auto rr = __builtin_amdgcn_permlane32_swap(__float_as_uint(m), __float_as_uint(m), false, false); return fmaxf(__uint_as_float(rr[0]), __uint_as_float(rr[1])); }
DI float xhalf_sum(float v) { auto rr = __builtin_amdgcn_permlane32_swap(__float_as_uint(v), __float_as_uint(v), false, false); return __uint_as_float(rr[0]) + __uint_as_float(rr[1]); }
DI float xhalf_other(float v) { const unsigned b = __float_as_uint(v); auto rr = __builtin_amdgcn_permlane32_swap(b, b, false, false); return __uint_as_float(rr[0] ^ rr[1] ^ b); }
DI void store_pair16(bf16_t* base32, u32x2 wa, u32x2 wb, int k, int h) {
    auto rx = __builtin_amdgcn_permlane32_swap(wa.x, wb.x, false, false);
    auto ry = __builtin_amdgcn_permlane32_swap(wa.y, wb.y, false, false);
    u32x4 w; w.x = rx[0]; w.y = ry[0]; w.z = rx[1]; w.w = ry[1];
    *(u32x4*)(base32 + 8 * (2 * k + h)) = w;
}
DI float silu_(float g) { return g * fast_rcp(1.f + fast_exp2(-g * LOG2E)); }
DI void write_y(const f32x16& o0, const f32x16& o1, float scale, const bf16_t* grow, bf16_t* yrow, int h) {
#pragma unroll
    for (int dh = 0; dh < 2; ++dh) {
        u32x2 w[4];
#pragma unroll
        for (int grp = 0; grp < 4; ++grp) {
            const int d0 = 32 * dh + 8 * grp + 4 * h;
            const u32x2 g = *(const u32x2*)(grow + d0);
            const f32x16& o = dh ? o1 : o0;
            const float y0 = o[4 * grp + 0] * scale * silu_(bflo(g.x)), y1 = o[4 * grp + 1] * scale * silu_(bfhi(g.x));
            const float y2 = o[4 * grp + 2] * scale * silu_(bflo(g.y)), y3 = o[4 * grp + 3] * scale * silu_(bfhi(g.y));
            w[grp].x = cvtpk(y0, y1); w[grp].y = cvtpk(y2, y3);
        }
        store_pair16(yrow + 32 * dh, w[0], w[1], 0, h);
        store_pair16(yrow + 32 * dh, w[2], w[3], 1, h);
    }
}
DI void load_q(bf16x8 (&qf)[4], const bf16_t* qrow, int h) {
#pragma unroll
    for (int s = 0; s < 4; ++s) qf[s] = *(const bf16x8*)(qrow + 16 * s + 8 * h);
}

DI void coop_load_tiles(const bf16_t* kbase, int vdelta, int t_hi, int nt, LAS unsigned char* lds, int wid, int lane) {
#pragma unroll 1
    for (int s0 = 0; s0 < nt; s0 += 4) {
        u32x4 kr[4], vr[4];
#pragma unroll
        for (int s = 0; s < 4; ++s) if (s0 + s < nt) { const bf16_t* src = kbase + (size_t)((t_hi - s0 - s) * 64 + lane) * PITCH + 8 * wid; kr[s] = *(const u32x4*)src; vr[s] = *(const u32x4*)(src + vdelta); }
#pragma unroll
        for (int s = 0; s < 4; ++s) if (s0 + s < nt) { *(LAS u32x4*)(lds + (s0 + s) * 16384 + wid * 1024 + lane * 16) = kr[s];
            *(LAS u32x4*)(lds + (s0 + s) * 16384 + 8192 + (wid >> 2) * 4096 + lane * 64 + (wid & 3) * 16) = vr[s]; }
    }
}
DI void sb_wg_unit(bf16_t* act, int b, int hh, int Qb, LAS unsigned char* lds, volatile LAS unsigned* ctl, int tid, int wid, int lane) {
    const int r = lane & 31, h = lane >> 5;
    const int Q = Qb * 256, q0 = Q + 32 * wid, qpos = q0 + r;
    const size_t rowq = (size_t)b * SEQ + qpos;
    bf16x8 qf[4]; load_q(qf, act + rowq * PITCH + C_QA + hh * 64, h);
    f32x16 o0, o1;
#pragma unroll
    for (int i = 0; i < 16; ++i) { o0[i] = 0.f; o1[i] = 0.f; }
    float C = 1.f;
    const bf16_t* kgb = act + (size_t)b * SEQ * PITCH + C_KA + hh * 64;
    int t = q0 >> 6;
    bool done = false;
    int t_top = (Q >> 6) + 3;
#pragma unroll 1
    for (;;) {
        const int t_bot = (t_top - 7) > 0 ? (t_top - 7) : 0, nt = t_top - t_bot + 1;
        __syncthreads();
        if (tid == 0) ctl[7] = 0u;
        coop_load_tiles(kgb, C_VA - C_KA, t_top, nt, lds, wid, lane);
        __syncthreads();
#pragma unroll 1
        while (!done && t >= t_bot) {
            const int kv0 = t * 64;
            LAS const unsigned char* Ks = lds + (t_top - t) * 16384; LAS const unsigned char* Vs = Ks + 8192;
            f32x16 p0, p1;
#pragma unroll
            for (int i = 0; i < 16; ++i) { p0[i] = 0.f; p1[i] = 0.f; }
            qk_tile(p0, p1, Ks, qf, r, h);
            const bool diag = (kv0 + 63 >= q0);
            f32x16 F0, F1;
#pragma unroll
            for (int i = 0; i < 16; ++i) {
                const int kl = (i & 3) + 8 * (i >> 2) + 4 * h;
                { const float e = fast_exp2(fminf(p0[i], 60.f)); const float f = fast_rcp(1.f + e);
                  const bool valid = !diag || (kv0 + kl < qpos); F0[i] = valid ? f : 1.f; p0[i] = valid ? e * f : 0.f; }
                { const float e = fast_exp2(fminf(p1[i], 60.f)); const float f = fast_rcp(1.f + e);
                  const bool valid = !diag || (kv0 + 32 + kl < qpos); F1[i] = valid ? f : 1.f; p1[i] = valid ? e * f : 0.f; }
            }
            float G[8], Go[8];
#pragma unroll
            for (int g = 0; g < 4; ++g) { G[g] = (F0[4 * g] * F0[4 * g + 1]) * (F0[4 * g + 2] * F0[4 * g + 3]); G[4 + g] = (F1[4 * g] * F1[4 * g + 1]) * (F1[4 * g + 2] * F1[4 * g + 3]); }
#pragma unroll
            for (int g = 0; g < 8; ++g) Go[g] = xhalf_other(G[g]);
            float run = C; float A[8];
#pragma unroll
            for (int g = 7; g >= 0; --g) { A[g] = run * (h == 0 ? Go[g] : 1.f); run *= (G[g] * Go[g]); }
#pragma unroll
            for (int g = 0; g < 4; ++g) {
                { float bt = A[g]; p0[4 * g + 3] *= bt; bt *= F0[4 * g + 3]; p0[4 * g + 2] *= bt; bt *= F0[4 * g + 2]; p0[4 * g + 1] *= bt; bt *= F0[4 * g + 1]; p0[4 * g] *= bt; }
                { float bt = A[4 + g]; p1[4 * g + 3] *= bt; bt *= F1[4 * g + 3]; p1[4 * g + 2] *= bt; bt *= F1[4 * g + 2]; p1[4 * g + 1] *= bt; bt *= F1[4 * g + 1]; p1[4 * g] *= bt; }
            }
            C = run;
            pv_tile(o0, o1, Vs, p0, p1, lane);
            if (__all(C < 1.17549435e-38f)) done = true;
            --t;
        }
        if (t < 0) done = true;
        if (!done && lane == 0) ctl[7] = 1u;
        __syncthreads();
        if (ctl[7] == 0u) break;
        t_top = t_bot - 1;
    }
    write_y(o0, o1, 1.0f, act + rowq * PITCH + C_GA + hh * 64, act + rowq * PITCH + C_QA + hh * 64, h);
}
DI void swa_wg_unit(bf16_t* act, int b, int hk, int Qb, const float* sinks_l, LAS const float* tabS, LAS unsigned char* lds, int wid, int lane) {
    const int r = lane & 31, h = lane >> 5;
    const int Q = Qb * 256, q0 = Q + 32 * wid, qpos = q0 + r;
    const size_t rowq = (size_t)b * SEQ + qpos;
    const int t_hi = (Q >> 6) + 3, t_lo = (Q >= 128) ? ((Q - 128) >> 6) : 0;
    __syncthreads();
    coop_load_tiles(act + (size_t)b * SEQ * PITCH + C_KC + hk * 64, C_VC - C_KC, t_hi, t_hi - t_lo + 1, lds, wid, lane);
    __syncthreads();
    const int tlo = (q0 >= 127) ? ((q0 - 127) >> 6) : 0;
#pragma unroll 1
    for (int g = 0; g < 4; ++g) {
        const int hq = 4 * hk + g;
        LAS const float* tab = tabS + hq * 128;
        bf16x8 qf[4]; load_q(qf, act + rowq * PITCH + C_QC + hq * 64, h);
        f32x16 o0, o1;
#pragma unroll
        for (int i = 0; i < 16; ++i) { o0[i] = 0.f; o1[i] = 0.f; }
        float m = sinks_l[hq] * LOG2E, l = (h == 0) ? 1.0f : 0.f;
        for (int t = tlo; t <= (q0 >> 6); ++t) {
            const int kv0 = t * 64;
            LAS const unsigned char* Ks = lds + (t_hi - t) * 16384; LAS const unsigned char* Vs = Ks + 8192;
            f32x16 p0, p1;
#pragma unroll
            for (int i = 0; i < 16; ++i) { p0[i] = 0.f; p1[i] = 0.f; }
            qk_tile(p0, p1, Ks, qf, r, h);
            const int dq = qpos - kv0 - 4 * h;
            float tmax = NEG_INF;
#pragma unroll
            for (int half = 0; half < 2; ++half) {
                float tb[16];
#pragma unroll
                for (int i = 0; i < 16; ++i) { const int d = dq - 32 * half - ((i & 3) + 8 * (i >> 2)); tb[i] = tab[d < 0 ? 0 : (d > 127 ? 127 : d)]; }
#pragma unroll
                for (int i = 0; i < 16; ++i) asm volatile("" : "+v"(tb[i]));
#pragma unroll
                for (int i = 0; i < 16; ++i) { const int d = dq - 32 * half - ((i & 3) + 8 * (i >> 2)); const bool valid = (unsigned)d < 128u;
                    if (half == 0) { p0[i] = valid ? p0[i] + tb[i] : NEG_INF; tmax = fmaxf(tmax, p0[i]); } else { p1[i] = valid ? p1[i] + tb[i] : NEG_INF; tmax = fmaxf(tmax, p1[i]); } }
            }
            tmax = xhalf_max(tmax);
            const bool grow = (tmax - m) > 16.f;
            if (__ballot(grow) != 0ull) {
                const float mn = grow ? tmax : m, alpha = fast_exp2(m - mn);
                l *= alpha; m = mn;
#pragma unroll
                for (int i = 0; i < 16; ++i) { o0[i] *= alpha; o1[i] *= alpha; }
            }
            float ls = 0.f;
#pragma unroll
            for (int i = 0; i < 16; ++i) { p0[i] = fast_exp2(p0[i] - m); p1[i] = fast_exp2(p1[i] - m); ls += p0[i] + p1[i]; }
            l += ls;
            pv_tile(o0, o1, Vs, p0, p1, lane);
        }
        l = xhalf_sum(l);
        write_y(o0, o1, fast_rcp(l), act + rowq * PITCH + C_GC + hq * 64, act + rowq * PITCH + C_QC + hq * 64, h);
    }
}

DI void moba_kmean_frags(bf16x8 (&khi)[4], bf16x8 (&klo)[4], const float* kpart, int b, int hh, int lane) {
    const int r = lane & 31, h = lane >> 5;
    const float* kp = kpart + ((size_t)(b * 32 + r) * 2) * 512 + hh * 64;
    f32x4 a0[4], a1[4], b0[4], b1[4];
#pragma unroll
    for (int s = 0; s < 4; ++s) { const int d = 16 * s + 8 * h; a0[s] = *(const f32x4*)(kp + d); a1[s] = *(const f32x4*)(kp + d + 4); b0[s] = *(const f32x4*)(kp + 512 + d); b1[s] = *(const f32x4*)(kp + 512 + d + 4); }
#pragma unroll
    for (int s = 0; s < 4; ++s) {
        float km[8];
#pragma unroll
        for (int j = 0; j < 4; ++j) { km[j] = (a0[s][j] + b0[s][j]) * (1.0f / 256.0f); km[4 + j] = (a1[s][j] + b1[s][j]) * (1.0f / 256.0f); }
        u32x4 hi4, lo4;
        hi4.x = cvtpk(km[0], km[1]); hi4.y = cvtpk(km[2], km[3]); hi4.z = cvtpk(km[4], km[5]); hi4.w = cvtpk(km[6], km[7]);
        lo4.x = cvtpk(km[0] - bflo(hi4.x), km[1] - bfhi(hi4.x)); lo4.y = cvtpk(km[2] - bflo(hi4.y), km[3] - bfhi(hi4.y));
        lo4.z = cvtpk(km[4] - bflo(hi4.z), km[5] - bfhi(hi4.z)); lo4.w = cvtpk(km[6] - bflo(hi4.w), km[7] - bfhi(hi4.w));
        khi[s] = __builtin_bit_cast(bf16x8, hi4); klo[s] = __builtin_bit_cast(bf16x8, lo4);
    }
}
DI void moba_sel_core(const bf16x8 (&qf)[4], const bf16x8 (&khi)[4], const bf16x8 (&klo)[4], unsigned* sel, int b, int hh, int q0, int lane) {
    const int r = lane & 31, h = lane >> 5;
    const int qpos = q0 + r, own = q0 >> 8;
    unsigned smask = 0u;
    f32x16 g;
#pragma unroll
    for (int i = 0; i < 16; ++i) g[i] = 0.f;
#pragma unroll
    for (int s = 0; s < 4; ++s) { g = MFMA32(khi[s], qf[s], g); g = MFMA32(klo[s], qf[s], g); }
    float gv[16];
#pragma unroll
    for (int i = 0; i < 16; ++i) { const int j = (i & 3) + 8 * (i >> 2) + 4 * h; gv[i] = (j < own) ? g[i] : NEG_INF; }
#pragma unroll
    for (int it = 0; it < 3; ++it) {
        float bv = NEG_INF; int bj = 64;
#pragma unroll
        for (int i = 0; i < 16; ++i) { const int j = (i & 3) + 8 * (i >> 2) + 4 * h; if (gv[i] > bv) { bv = gv[i]; bj = j; } }
        const float ov = __shfl_xor(bv, 32); const int oj = __shfl_xor(bj, 32);
        const bool mine = (bv > ov) || (bv == ov && bj < oj);
        const float wv = mine ? bv : ov; const int wj = mine ? bj : oj;
        if (wv > NEG_INF) smask |= (1u << wj);
#pragma unroll
        for (int i = 0; i < 16; ++i) { const int j = (i & 3) + 8 * (i >> 2) + 4 * h; if (mine && j == bj) gv[i] = NEG_INF; }
    }
    if (h == 0) sel[(size_t)(b * 8 + hh) * SEQ + qpos] = smask;
}
DI void moba_sel_quad(const bf16_t* act, const bf16x8 (&khi)[4], const bf16x8 (&klo)[4], unsigned* sel, int b, int hh, int q0, int lane) {
    const int r = lane & 31, h = lane >> 5;
    bf16x8 q0f[4], q1f[4], q2f[4], q3f[4];
    const bf16_t* base = act + ((size_t)b * SEQ + q0 + r) * PITCH + C_QB + hh * 64;
    load_q(q0f, base, h); load_q(q1f, base + (size_t)32 * PITCH, h); load_q(q2f, base + (size_t)64 * PITCH, h); load_q(q3f, base + (size_t)96 * PITCH, h);
    moba_sel_core(q0f, khi, klo, sel, b, hh, q0, lane);
    moba_sel_core(q1f, khi, klo, sel, b, hh, q0 + 32, lane);
    moba_sel_core(q2f, khi, klo, sel, b, hh, q0 + 64, lane);
    moba_sel_core(q3f, khi, klo, sel, b, hh, q0 + 96, lane);
}
DI void moba_qk(f32x16& p0, f32x16& p1, float ci, LAS const unsigned char* Kt, const bf16x8 (&qf)[4], int r, int h) {
#pragma unroll
    for (int i = 0; i < 16; ++i) { p0[i] = ci; p1[i] = ci; }
    qk_tile(p0, p1, Kt, qf, r, h);
}
DI void moba_softpv(f32x16& c0, f32x16& c1, f32x16& n0, f32x16& n1, bool has_next, bool first, int qpos, int kv0, float& m, float& l, f32x16& o0, f32x16& o1,
                    float bfar, LAS const float* tab, LAS const unsigned char* Vt, int lane) {
    const int h = lane >> 5;
    if (__ballot((qpos - (kv0 + 63)) < 128) != 0ull) {
        const int dq = qpos - kv0 - 4 * h;
#pragma unroll
        for (int half = 0; half < 2; ++half) {
            float tb[16];
#pragma unroll
            for (int i = 0; i < 16; ++i) { const int d = dq - 32 * half - ((i & 3) + 8 * (i >> 2)); tb[i] = tab[d < 0 ? 0 : (d > 128 ? 128 : d)]; }
#pragma unroll
            for (int i = 0; i < 16; ++i) asm volatile("" : "+v"(tb[i]));
#pragma unroll
            for (int i = 0; i < 16; ++i) { const int d = dq - 32 * half - ((i & 3) + 8 * (i >> 2));
                if (half == 0) c0[i] = (d >= 0) ? c0[i] + (tb[i] - bfar) : NEG_INF; else c1[i] = (d >= 0) ? c1[i] + (tb[i] - bfar) : NEG_INF; }
        }
    }
    float tmax = NEG_INF;
#pragma unroll
    for (int i = 0; i < 16; ++i) tmax = fmaxf(tmax, fmaxf(c0[i], c1[i]));
    tmax = xhalf_max(tmax);
    const bool out_of_band = first ? (fabsf(tmax) > 16.f && tmax > -1e30f) : (tmax > 16.f);
    if (__ballot(out_of_band) != 0ull) {
        const float dl = out_of_band ? tmax : 0.f, alpha = first ? 1.0f : fast_exp2(-dl);
        m += dl; l *= alpha;
#pragma unroll
        for (int i = 0; i < 16; ++i) { c0[i] -= dl; c1[i] -= dl; o0[i] *= alpha; o1[i] *= alpha; }
        if (has_next) {
#pragma unroll
            for (int i = 0; i < 16; ++i) { n0[i] -= dl; n1[i] -= dl; }
        }
    }
    float ls = 0.f;
#pragma unroll
    for (int i = 0; i < 16; ++i) { c0[i] = fast_exp2(c0[i]); c1[i] = fast_exp2(c1[i]); ls += c0[i] + c1[i]; }
    l += ls;
    pv_tile(o0, o1, Vt, c0, c1, lane);
}
DI void moba_group(bf16_t* act, float* ml, int b, int hh, int j, int qpos, int slot, const bf16x8 (&qf)[4], bool live, bool isdiag, int ntiles, LAS const float* tab, LAS const unsigned char* lds, int lane) {
    const int r = lane & 31, h = lane >> 5;
    const size_t rowq = (size_t)b * SEQ + qpos;
    f32x16 o0, o1;
#pragma unroll
    for (int i = 0; i < 16; ++i) { o0[i] = 0.f; o1[i] = 0.f; }
    float m = 0.f, l = 0.f;
    const float bfar = tab[128];
    const int kvb = j * 256;
    LAS const unsigned char* Vb = lds + 32768;
    f32x16 a0, a1, b0, b1;
    moba_qk(a0, a1, bfar, lds, qf, r, h);
    if (ntiles > 1) moba_qk(b0, b1, bfar, lds + 8192, qf, r, h);
    moba_softpv(a0, a1, b0, b1, ntiles > 1, true, qpos, kvb, m, l, o0, o1, bfar, tab, Vb, lane);
    if (ntiles > 1) {
        if (ntiles > 2) moba_qk(a0, a1, bfar - m, lds + 2 * 8192, qf, r, h);
        moba_softpv(b0, b1, a0, a1, ntiles > 2, false, qpos, kvb + 64, m, l, o0, o1, bfar, tab, Vb + 8192, lane);
        if (ntiles > 2) {
            if (ntiles > 3) moba_qk(b0, b1, bfar - m, lds + 3 * 8192, qf, r, h);
            moba_softpv(a0, a1, b0, b1, ntiles > 3, false, qpos, kvb + 128, m, l, o0, o1, bfar, tab, Vb + 2 * 8192, lane);
            if (ntiles > 3) moba_softpv(b0, b1, a0, a1, false, false, qpos, kvb + 192, m, l, o0, o1, bfar, tab, Vb + 3 * 8192, lane);
        }
    }
    l = xhalf_sum(l);
    const float inv = fast_rcp(l);
    u32x4 wq[2][2];
#pragma unroll
    for (int dh = 0; dh < 2; ++dh) {
        const f32x16& o = dh ? o1 : o0;
        u32x2 w[4];
#pragma unroll
        for (int grp = 0; grp < 4; ++grp) { w[grp].x = cvtpk(o[4 * grp] * inv, o[4 * grp + 1] * inv); w[grp].y = cvtpk(o[4 * grp + 2] * inv, o[4 * grp + 3] * inv); }
#pragma unroll
        for (int k = 0; k < 2; ++k) {
            auto rx = __builtin_amdgcn_permlane32_swap(w[2 * k].x, w[2 * k + 1].x, false, false);
            auto ry = __builtin_amdgcn_permlane32_swap(w[2 * k].y, w[2 * k + 1].y, false, false);
            wq[dh][k].x = rx[0]; wq[dh][k].y = ry[0]; wq[dh][k].z = rx[1]; wq[dh][k].w = ry[1];
        }
    }
    if (live) {
        bf16_t* prow = act + rowq * PITCH + (slot < 3 ? (C_KA + (slot * 8 + hh) * 64) : (C_KC + hh * 64));
#pragma unroll
        for (int dh = 0; dh < 2; ++dh)
#pragma unroll
            for (int k = 0; k < 2; ++k) *(u32x4*)(prow + 32 * dh + 8 * (2 * k + h)) = wq[dh][k];

        if (h == 0) { float* mp = ml + ((rowq * 8 + hh) * 4 + slot) * 2; mp[0] = m; mp[1] = l; }
    }
}
struct MobaGrp { int qpos, slot, ntiles; bool live, isdiag; };
DI bool moba_prepare(MobaGrp& G, bf16x8 (&qf)[4], const bf16_t* act, int b, int hh, int j, int total, int g, volatile LAS unsigned short* list, int lane) {
    const int r = lane & 31, h = lane >> 5;
    const int ng = 8 + ((total + 31) >> 5);
    if (g >= ng) return false;
    if (g < 8) { const int slice = 7 - g; G.qpos = j * 256 + slice * 32 + r; G.slot = 3; G.ntiles = (slice >> 1) + 1; G.live = true; G.isdiag = true; }
    else { const int gi = g - 8, idx = gi * 32 + r; G.live = idx < total; const unsigned e = list[G.live ? idx : gi * 32]; G.qpos = (int)(e & 0x1fffu); G.slot = (int)(e >> 13); G.ntiles = 4; G.isdiag = false; }
    load_q(qf, act + ((size_t)b * SEQ + G.qpos) * PITCH + C_QB + hh * 64, h);
    return true;
}
DI void moba_block_phase(bf16_t* act, const unsigned* sel, float* ml, unsigned* qctr, LAS const float* tabM, LAS unsigned char* lds, int tid, int wid, int lane) {
    volatile LAS unsigned* ctl = (volatile LAS unsigned*)(lds + LDS_CTL);
    volatile LAS unsigned short* list = (volatile LAS unsigned short*)(lds + 65536);
    unsigned* gctr = (unsigned*)(LAS unsigned*)(lds + LDS_CTL + 5 * 4);
    if (tid == 0) ctl[6] = __hip_atomic_fetch_add(qctr, 1u, __ATOMIC_RELAXED, __HIP_MEMORY_SCOPE_AGENT);
    for (;;) {
        __syncthreads();
        const unsigned u = ctl[6];
        if (u >= 1024u) break;
        const int j = (int)(u >> 5), bh = (int)(u & 31u), b = bh >> 3, hh = bh & 7;
        const unsigned* selp = sel + (size_t)bh * SEQ;
        const int C = (31 - j) * 32, base = (j + 1) * 256 + wid * C;
        unsigned words[16];
#pragma unroll
        for (int k = 0; k < 16; ++k) { const int idx = k * 64 + lane; const unsigned w = selp[base + (idx < C ? idx : 0)]; words[k] = (idx < C) ? w : 0u; }
        {
            const bf16_t* kb = act + ((size_t)b * SEQ + j * 256 + lane) * PITCH + C_KB + hh * 64 + 8 * wid;
            u32x4 kreg[4], vreg[4];
#pragma unroll
            for (int t = 0; t < 4; ++t) { kreg[t] = *(const u32x4*)(kb + (size_t)t * 64 * PITCH); vreg[t] = *(const u32x4*)(kb + (size_t)t * 64 * PITCH + (C_VB - C_KB)); }
#pragma unroll
            for (int t = 0; t < 4; ++t) { *(LAS u32x4*)(lds + t * 8192 + wid * 1024 + lane * 16) = kreg[t];
                *(LAS u32x4*)(lds + 32768 + t * 8192 + (wid >> 2) * 4096 + lane * 64 + (wid & 3) * 16) = vreg[t]; }
        }
        int cnt = 0;
#pragma unroll
        for (int k = 0; k < 16; ++k) cnt += __popcll(__ballot(((words[k] >> j) & 1u) != 0u));
        if (lane == 0) ctl[8 + wid] = (unsigned)cnt;
        if (tid == 0) ctl[5] = 0u;
        __syncthreads();
        unsigned nxt_unit = 0u;
        if (tid == 0) nxt_unit = __hip_atomic_fetch_add(qctr, 1u, __ATOMIC_RELAXED, __HIP_MEMORY_SCOPE_AGENT);
        int off = 0, total = 0;
#pragma unroll
        for (int w = 0; w < 8; ++w) { const int c = (int)ctl[8 + w]; off += (w < wid) ? c : 0; total += c; }
#pragma unroll
        for (int k = 0; k < 16; ++k) {
            const bool match = ((words[k] >> j) & 1u) != 0u;
            const unsigned long long mask = __ballot(match);
            if (match) list[off + __popcll(mask & ((1ull << lane) - 1ull))] = (unsigned short)((unsigned)(base + k * 64 + lane) | ((unsigned)__popc(words[k] & ((1u << j) - 1u)) << 13));
            off += __popcll(mask);
        }
        __syncthreads();
        LAS const float* tab = tabM + hh * 132;
        MobaGrp Ga; bf16x8 qa[4];
        for (;;) {
            int g = 0; if (lane == 0) g = (int)__hip_atomic_fetch_add(gctr, 1u, __ATOMIC_RELAXED, __HIP_MEMORY_SCOPE_WORKGROUP);
            g = __builtin_amdgcn_readfirstlane(g);
            if (!moba_prepare(Ga, qa, act, b, hh, j, total, g, list, lane)) break;
            moba_group(act, ml, b, hh, j, Ga.qpos, Ga.slot, qa, Ga.live, Ga.isdiag, Ga.ntiles, tab, lds, lane);
        }
        if (tid == 0) ctl[6] = nxt_unit;
    }
}
DI void moba_combine_token(bf16_t* act, const unsigned* sel, const float* ml, int tok, int lane) {
    const int hh = lane >> 3, ch = lane & 7;
    const int b = tok >> 13, qpos = tok & (SEQ - 1);
    bf16_t* rowp = act + (size_t)tok * PITCH;
    const unsigned word = sel[(size_t)(b * 8 + hh) * SEQ + qpos];
    const f32x4* mlp = (const f32x4*)(ml + ((size_t)tok * 8 + hh) * 8);
    const f32x4 a = mlp[0], c = mlp[1];
    const u32x4 v3 = *(const u32x4*)(rowp + C_KC + hh * 64 + ch * 8);
    u32x4 vs[3];
#pragma unroll
    for (int s = 0; s < 3; ++s) vs[s] = *(const u32x4*)(rowp + C_KA + (s * 8 + hh) * 64 + ch * 8);
    const u32x4 g = *(const u32x4*)(rowp + C_GB + hh * 64 + ch * 8);
    const int ns = __popc(word);
    const float m0 = ns > 0 ? a.x : NEG_INF, m1 = ns > 1 ? a.z : NEG_INF, m2 = ns > 2 ? c.x : NEG_INF, m3 = c.z;
    const float M = fmaxf(fmaxf(m0, m1), fmaxf(m2, m3));
    const float w0 = ns > 0 ? a.y * fast_exp2(m0 - M) : 0.f, w1 = ns > 1 ? a.w * fast_exp2(m1 - M) : 0.f, w2 = ns > 2 ? c.y * fast_exp2(m2 - M) : 0.f, w3 = c.w * fast_exp2(m3 - M);
    const float inv = fast_rcp((w0 + w1) + (w2 + w3));
    float acc[8];
    acc[0] = w3 * bflo(v3.x); acc[1] = w3 * bfhi(v3.x); acc[2] = w3 * bflo(v3.y); acc[3] = w3 * bfhi(v3.y); acc[4] = w3 * bflo(v3.z); acc[5] = w3 * bfhi(v3.z); acc[6] = w3 * bflo(v3.w); acc[7] = w3 * bfhi(v3.w);
#pragma unroll
    for (int s = 0; s < 3; ++s) {
        const float w = s == 0 ? w0 : (s == 1 ? w1 : w2);
        const bool use = s < ns;
        u32x4 v = vs[s]; if (!use) v = (u32x4){0u, 0u, 0u, 0u};
        acc[0] += w * bflo(v.x); acc[1] += w * bfhi(v.x); acc[2] += w * bflo(v.y); acc[3] += w * bfhi(v.y); acc[4] += w * bflo(v.z); acc[5] += w * bfhi(v.z); acc[6] += w * bflo(v.w); acc[7] += w * bfhi(v.w);
    }
    u32x4 y;
    y.x = cvtpk(acc[0] * inv * silu_(bflo(g.x)), acc[1] * inv * silu_(bfhi(g.x))); y.y = cvtpk(acc[2] * inv * silu_(bflo(g.y)), acc[3] * inv * silu_(bfhi(g.y)));
    y.z = cvtpk(acc[4] * inv * silu_(bflo(g.z)), acc[5] * inv * silu_(bfhi(g.z))); y.w = cvtpk(acc[6] * inv * silu_(bflo(g.w)), acc[7] * inv * silu_(bfhi(g.w)));
    *(u32x4*)(rowp + C_QB + hh * 64 + ch * 8) = y;
}

__global__ void __launch_bounds__(512, 2) hybrid_fwd(Params p) {
    extern __shared__ __attribute__((aligned(16))) unsigned char lds_raw[];
    cg::grid_group grid = cg::this_grid();
    LAS unsigned char* lds = (LAS unsigned char*)lds_raw;
    const int G = gridDim.x, wg = blockIdx.x;
#define PHASE_VARS \
    int tid = threadIdx.x; asm volatile("" : "+v"(tid)); \
    const int lane = tid & 63, wid = __builtin_amdgcn_readfirstlane(tid >> 6); \
    const int gw = wg * 8 + wid, NGW = G * 8; (void)gw; (void)NGW; (void)lane; \
    size_t zoff_ = 0; asm volatile("" : "+s"(zoff_)); unsigned char* ws = p.ws + zoff_; \
    bf16_t* win = (bf16_t*)(ws + WS_WIN); bf16_t* wp = (bf16_t*)(ws + WS_WP); bf16_t* wo = (bf16_t*)(ws + WS_WO); (void)win; (void)wp; (void)wo; \
    float* ssq = (float*)(ws + WS_SSQ); float* kpart = (float*)(ws + WS_KPART); bf16_t* act = (bf16_t*)(ws + WS_ACT); (void)ssq; (void)kpart; (void)act; \
    LAS float* tabM = (LAS float*)(lds + LDS_TABM); LAS float* tabS = (LAS float*)(lds + LDS_TABS); (void)tabM; (void)tabS;

    if (threadIdx.x < 16) ((LAS unsigned*)(lds + LDS_CTL))[threadIdx.x] = 0u;
    __syncthreads();
    const XcdBarrier xbar = xcd_barrier_post((unsigned*)(p.ws + WS_CTL), (volatile LAS unsigned*)(lds + LDS_CTL));
#define GRID_BAR() xcd_barrier(xbar)
    if (p.sinks[0] > 1.0e30f) grid.sync();
    { PHASE_VARS
    for (int idx = tid; idx < 8 * 129; idx += 512) {
        const int hh = idx / 129, d = idx - hh * 129;
        int bk = d; if (d >= 16) { bk = 16 + (int)(logf((float)d / 16.0f) / 2.0794415416798357f * 16.0f); if (bk > 31) bk = 31; }
        tabM[hh * 132 + d] = p.rel_bias[bk * 16 + hh] * LOG2E;
        if (d < 128) tabS[hh * 128 + d] = p.rel_bias[bk * 16 + 8 + hh] * LOG2E;
    }

    {
        LAS float* scr = (LAS float*)(lds + wid * 16384);
        constexpr int I_IN = (DM / 64) * (DIN / 32), I_P = (512 / 64) * (DM / 32), I_O = (DM / 64) * (DM / 32);
        constexpr int PER_L = I_IN + 3 * I_P + I_O;
        auto decode = [&](int it) {
            TrItem t; const int l = it / PER_L; int rr = it - l * PER_L;
            if (rr < I_IN) { t.W = p.w_in + (size_t)l * DM * DIN; t.N = DIN; t.WT = win + (size_t)l * DIN * DM; t.ldwt = DM; t.ks = p.norm_w + l * DM; t.item = rr; return t; }
            rr -= I_IN;
            if (rr < 3 * I_P) { const int br = rr / I_P; rr -= br * I_P; t.W = (br == 0 ? p.w_pa : br == 1 ? p.w_pb : p.w_pc) + (size_t)l * 512 * DM; t.N = DM;
                t.WT = wp + ((size_t)(l * 3 + br) * 1024) * 1024; t.ldwt = 1024; t.ks = nullptr; t.item = rr; return t; }
            rr -= 3 * I_P;
            t.W = p.w_out + (size_t)l * DM * DM; t.N = DM; t.WT = wo + (size_t)l * DM * DM; t.ldwt = DM; t.ks = nullptr; t.item = rr; return t;
        };
        {
            f32x4 va[8], vb[8]; float sa[8], sb[8];
            int it = gw;
            TrItem ta, tb;
            if (it < PER_L) { ta = decode(it); tr_load(va, sa, ta, lane); }
            while (it < PER_L) {
                const int itn = it + NGW; const bool hn = itn < PER_L;
                if (hn) { tb = decode(itn); tr_load(vb, sb, tb, lane); }
                tr_finish(va, sa, ta, scr, lane);
                if (!hn) break;
                const int itn2 = itn + NGW; const bool hn2 = itn2 < PER_L;
                if (hn2) { ta = decode(itn2); tr_load(va, sa, ta, lane); }
                tr_finish(vb, sb, tb, scr, lane);
                if (!hn2) break;
                it = itn2;
            }
        }
        {
            f32x4 va[4], vb[4];
            int row = gw;
            if (row < T) {
#pragma unroll
                for (int j = 0; j < 4; ++j) va[j] = ((const f32x4*)(p.x + (size_t)row * DM) + lane)[64 * j];
            }
            while (row < T) {
                const int rn_ = row + NGW; const bool hn = rn_ < T;
                if (hn) {
#pragma unroll
                    for (int j = 0; j < 4; ++j) vb[j] = ((const f32x4*)(p.x + (size_t)rn_ * DM) + lane)[64 * j];
                }
                { float s = 0.f;
#pragma unroll
                  for (int j = 0; j < 4; ++j) s += (va[j].x * va[j].x + va[j].y * va[j].y) + (va[j].z * va[j].z + va[j].w * va[j].w);
                  s = wave_sum(s);
                  const float rn = 1.0f / sqrtf(s * (1.0f / DM) + RMS_EPS);
                  u32x2* o8 = (u32x2*)(act + (size_t)row * PITCH + XB_COL) + lane;
#pragma unroll
                  for (int j = 0; j < 4; ++j) { u32x2 w; w.x = cvtpk(va[j].x * rn, va[j].y * rn); w.y = cvtpk(va[j].z * rn, va[j].w * rn); o8[64 * j] = w; }
                  if (lane < 16) ssq[(size_t)row * 16 + lane] = (lane == 0) ? s : 0.f; }
                if (!hn) break;
                const int rn2_ = rn_ + NGW; const bool hn2 = rn2_ < T;
                if (hn2) {
#pragma unroll
                    for (int j = 0; j < 4; ++j) va[j] = ((const f32x4*)(p.x + (size_t)rn2_ * DM) + lane)[64 * j];
                }
                { float s = 0.f;
#pragma unroll
                  for (int j = 0; j < 4; ++j) s += (vb[j].x * vb[j].x + vb[j].y * vb[j].y) + (vb[j].z * vb[j].z + vb[j].w * vb[j].w);
                  s = wave_sum(s);
                  const float rn = 1.0f / sqrtf(s * (1.0f / DM) + RMS_EPS);
                  u32x2* o8 = (u32x2*)(act + (size_t)rn_ * PITCH + XB_COL) + lane;
#pragma unroll
                  for (int j = 0; j < 4; ++j) { u32x2 w; w.x = cvtpk(vb[j].x * rn, vb[j].y * rn); w.y = cvtpk(vb[j].z * rn, vb[j].w * rn); o8[64 * j] = w; }
                  if (lane < 16) ssq[(size_t)rn_ * 16 + lane] = (lane == 0) ? s : 0.f; }
                if (!hn2) break;
                row = rn2_;
            }
        }
    }
    }
    GRID_BAR();

#pragma unroll 1
    for (int layer = 0; layer < DEPTH; ++layer) {
        { PHASE_VARS
          const char* win_l = (const char*)(win + (size_t)layer * DIN * DM);
          SchedIn S; S.O.init(T / 256, NU / 256, G, wg); S.act = (const char*)act; S.win = win_l;
          LAS float* rsl = (LAS float*)(lds + LDS_RS);
          if (layer != 0) {
              const int rr = tid & 255;
              for (int i = tid >> 8; i < 12; i += 2) { pg8::Tile tt; if (!S.O.tile(i, tt)) break; rsl[i * 256 + rr] = row_rstd(ssq, tt.pm * 256 + rr); }
              __syncthreads();
          }
          EpiIn E{act, ssq, kpart, layer != 0, rsl};
          pg8::gemm_phase<EpiIn, SchedIn>(lds, PITCH, DM, S, E); }
        {
          PHASE_VARS
          int first_idle = (T / 256) * (NU / 256) - 10 * G; if (first_idle < 0 || first_idle >= G) first_idle = 0;
          if (wg >= first_idle) {
              constexpr int I_IN = (DM / 64) * (DIN / 32), I_P = (512 / 64) * (DM / 32), I_O = (DM / 64) * (DM / 32);
              constexpr int PER_L = I_IN + 3 * I_P + I_O;
              const int lo = (layer == 0) ? PER_L : PER_L + I_IN, hi = (layer == 0) ? PER_L + I_IN : 2 * PER_L;
              weight_tiles_simple(p, win, wp, wo, (LAS float*)(lds + wid * 16384), lo + (wg - first_idle) * 8 + wid, hi, (G - first_idle) * 8, lane);
          }
        }
        GRID_BAR();
        {
            PHASE_VARS
            unsigned* sel = (unsigned*)(ws + WS_SEL);
            for (int u4 = gw; u4 < 2048; u4 += NGW) {
                const int hh = (u4 >> 6) & 7, b = u4 >> 9;
                bf16x8 khi[4], klo[4]; moba_kmean_frags(khi, klo, kpart, b, hh, lane);
                moba_sel_quad(act, khi, klo, sel, b, hh, (u4 & 63) * 128, lane);
            }
            volatile LAS unsigned* ctl = (volatile LAS unsigned*)(lds + LDS_CTL);
            for (int u = wg; u < 1024; u += G) {
                const int Qb = u & 31, hh = (u >> 5) & 7, b = u >> 8;
                sb_wg_unit(act, b, hh, Qb, lds, ctl, tid, wid, lane);
            }
            for (int u = wg; u < 256; u += G) {
                const int Qb = u & 31, hk = (u >> 5) & 1, b = u >> 6;
                swa_wg_unit(act, b, hk, Qb, p.sinks + layer * 8, tabS, lds, wid, lane);
            }
        }
        GRID_BAR();
        {
            PHASE_VARS
            moba_block_phase(act, (const unsigned*)(ws + WS_SEL), (float*)(ws + WS_ML), (unsigned*)(ws + WS_CTL) + XCD_BAR_WORDS + layer, tabM, lds, tid, wid, lane);
        }
        GRID_BAR();
        {
            PHASE_VARS
            for (int tok = gw; tok < T; tok += 2 * NGW) {
                moba_combine_token(act, (const unsigned*)(ws + WS_SEL), (const float*)(ws + WS_ML), tok, lane);
                if (tok + NGW < T) moba_combine_token(act, (const unsigned*)(ws + WS_SEL), (const float*)(ws + WS_ML), tok + NGW, lane);
            }
        }
        GRID_BAR();
        { PHASE_VARS
          const char* win_l = (const char*)(win + (size_t)layer * DIN * DM);
          const char* wp_l = (const char*)(wp + (size_t)layer * 3 * 1024 * 1024);
          SchedMerge S; S.O.init(T / 256, DM / 256, G, wg); S.act = (const char*)act; S.win = win_l; S.wp = wp_l;
          LAS float* rsl = (LAS float*)(lds + LDS_RS);
          if (layer != 0) { pg8::Tile tt; const int ti = tid >> 8; if (S.O.tile(ti, tt)) rsl[ti * 256 + (tid & 255)] = row_rstd(ssq, tt.pm * 256 + (tid & 255)); __syncthreads(); }
          EpiMerge E{act, ssq, layer != 0, rsl};
          pg8::gemm_phase<EpiMerge, SchedMerge>(lds, PITCH, DM, S, E); }
        GRID_BAR();
        { PHASE_VARS
          const char* wo_l = (const char*)(wo + (size_t)layer * DM * DM);
          SchedOut S; S.O.init(T / 256, DM / 256, G, wg); S.act = (const char*)act; S.wo = wo_l;
          EpiOut E{layer == 0 ? p.x : (const float*)p.out, p.out, act, ssq, layer == DEPTH - 1};
          pg8::gemm_phase<EpiOut, SchedOut>(lds, PITCH, DM, S, E); }
        GRID_BAR();
    }
    PHASE_VARS
    for (int row = gw; row < T; row += 2 * NGW) {
        const int row2 = (row + NGW < T) ? row + NGW : row;
        f32x4* xr = (f32x4*)(p.out + (size_t)row * DM) + lane; f32x4* xr2 = (f32x4*)(p.out + (size_t)row2 * DM) + lane;
        const f32x4* wr_ = (const f32x4*)(p.fnw) + lane;
        f32x4 v[4], v2[4], w[4];
#pragma unroll
        for (int j = 0; j < 4; ++j) { v[j] = xr[64 * j]; v2[j] = xr2[64 * j]; w[j] = wr_[64 * j]; }
        const float rs = row_rstd(ssq, row), rs2 = row_rstd(ssq, row2);
#pragma unroll
        for (int j = 0; j < 4; ++j) { xr[64 * j] = v[j] * rs * w[j]; if (row2 != row) xr2[64 * j] = v2[j] * rs2 * w[j]; }
    }
}

extern "C" void kernel_launch(void* const* d_in, const int* in_sizes, int n_in, void* d_out, int out_size, void* d_ws, size_t ws_size, hipStream_t stream) {
    static int grid = 0;
    if (grid == 0) {
        if (n_in != 10 || in_sizes[0] != T * DM || out_size != T * DM || ws_size < WS_END) { fprintf(stderr, "kernel_launch: unexpected shapes / workspace (%d inputs, ws %zu)\n", n_in, ws_size); grid = -1; return; }
        int dev = 0, cus = 0, per_cu = 0;
        (void)hipGetDevice(&dev);
        (void)hipDeviceGetAttribute(&cus, hipDeviceAttributeMultiprocessorCount, dev);
        if (hipFuncSetAttribute((const void*)hybrid_fwd, hipFuncAttributeMaxDynamicSharedMemorySize, LDS_BYTES) != hipSuccess) { fprintf(stderr, "kernel_launch: hipFuncSetAttribute failed\n"); grid = -1; return; }
        if (hipOccupancyMaxActiveBlocksPerMultiprocessor(&per_cu, (const void*)hybrid_fwd, 512, LDS_BYTES) != hipSuccess || per_cu < 1) { fprintf(stderr, "kernel_launch: occupancy query says %d\n", per_cu); per_cu = 1; }
        (void)hipGetLastError();
        grid = cus * (per_cu > 1 ? 1 : per_cu);
        if (grid <= 0) grid = 256;
    }
    if (grid < 0) return;
    Params p{};
    p.x = (const float*)d_in[0]; p.norm_w = (const float*)d_in[1]; p.w_in = (const float*)d_in[2]; p.w_pa = (const float*)d_in[3]; p.w_pb = (const float*)d_in[4];
    p.w_pc = (const float*)d_in[5]; p.w_out = (const float*)d_in[6]; p.sinks = (const float*)d_in[7]; p.rel_bias = (const float*)d_in[8]; p.fnw = (const float*)d_in[9];
    p.out = (float*)d_out; p.ws = (unsigned char*)d_ws;
    if (hipMemsetAsync((unsigned char*)d_ws + WS_CTL, 0, (size_t)(XCD_BAR_WORDS + 64) * 4, stream) != hipSuccess) { fprintf(stderr, "kernel_launch: hipMemsetAsync of the control words failed\n"); return; }
    void* args[] = {&p};
    hipError_t e = hipLaunchCooperativeKernel((const void*)hybrid_fwd, dim3(grid), dim3(512), args, LDS_BYTES, stream);
    if (e != hipSuccess) fprintf(stderr, "kernel_launch: cooperative launch failed: %s (grid %d)\n", hipGetErrorString(e), grid);
}
```
